# Optimizing an MI355X kernel written in HIP

```python
import math
import jax
import jax.numpy as jnp
from jax import lax
import numpy as np

D_MODEL = 2048
BATCH = 1
SEQ = 8192
DEPTH = 2

GRID_W = 64
CTX_LEN = 256
HEAD_DIM = 128
ROPE_THETA = 10000.0
EPS = 1e-6
NEG_INF = -1e30
Q_BLOCK = 128
N_MOD = 6

A_HEADS = D_MODEL // (2 * HEAD_DIM)
A_SUB = HEAD_DIM // 2
B_HEADS = D_MODEL // (2 * HEAD_DIM)
B_KV_HEADS = B_HEADS // 4
C_HEADS = D_MODEL // (2 * HEAD_DIM)
C_KV_HEADS = C_HEADS // 4
C_WINDOW = 128
C_BAND_SIDE = -(-C_WINDOW // Q_BLOCK)
D_HEADS = D_MODEL // (2 * HEAD_DIM)
NA_KH = 8
NA_KW = 16
D_FF = 5632
CONV_W = 3
N_EVEN = (DEPTH + 1) // 2
N_ODD = DEPTH // 2

EVEN_SIZES = (A_HEADS * 2 * A_SUB, A_HEADS * 2 * A_SUB, A_HEADS * HEAD_DIM,
              B_HEADS * HEAD_DIM, B_KV_HEADS * HEAD_DIM, B_KV_HEADS * HEAD_DIM)
ODD_SIZES = (C_HEADS * HEAD_DIM, C_KV_HEADS * HEAD_DIM, C_KV_HEADS * HEAD_DIM,
             D_HEADS * HEAD_DIM, D_HEADS * HEAD_DIM, D_HEADS * HEAD_DIM)
IN_WIDTH = sum(EVEN_SIZES)
MIX_WIDTH = (A_HEADS + B_HEADS) * HEAD_DIM

kernel_name = 'hybrid_diffattn_gqa_swa_natten_convffn'


def rms_norm(x, g):
    xf = x.astype(jnp.float32)
    y = xf * lax.rsqrt(jnp.mean(xf * xf, axis=-1, keepdims=True) + EPS)
    return (y * g.astype(jnp.float32)).astype(x.dtype)


def modulate(h, shift, scale):
    return h * (1 + scale) + shift


def split_cols(t, sizes):
    parts, off = [], 0
    for s in sizes:
        parts.append(t[..., off:off + s])
        off += s
    return parts


def rope_1d(x, pos):
    half = x.shape[-1] // 2
    freqs = ROPE_THETA ** (-jnp.arange(half, dtype=jnp.float32) / half)
    ang = pos.astype(jnp.float32)[:, None] * freqs[None, :]
    cos = jnp.cos(ang)[:, None, :]
    sin = jnp.sin(ang)[:, None, :]
    xf = x.astype(jnp.float32)
    x1, x2 = xf[..., :half], xf[..., half:]
    return jnp.concatenate([x1 * cos - x2 * sin, x2 * cos + x1 * sin], axis=-1).astype(x.dtype)


def rope_2d(x, rows, cols):
    h = x.shape[-1] // 2
    return jnp.concatenate([rope_1d(x[..., :h], rows), rope_1d(x[..., h:], cols)], axis=-1)


def sweep_query_blocks(fn, q):
    b, s = q.shape[:2]
    nb = s // Q_BLOCK
    qb = jnp.moveaxis(q.reshape((b, nb, Q_BLOCK) + q.shape[2:]), 1, 0)
    o = jnp.moveaxis(lax.map(fn, qb), 0, 1)
    return o.reshape((b, s) + o.shape[3:])


def gqa_attend(q, k, v):
    b, s, hq, d = q.shape
    hkv = k.shape[2]
    qg = q.reshape(b, s, hkv, hq // hkv, d)
    sc = jnp.einsum('bqhgd,bkhd->bhgqk', qg, k).astype(jnp.float32) * (d ** -0.5)
    p = jax.nn.softmax(sc, axis=-1).astype(v.dtype)
    o = jnp.einsum('bhgqk,bkhd->bqhgd', p, v)
    return o.reshape(b, s, hq, v.shape[-1])


def diff_attend(q, k, v, lam):
    sc = jnp.einsum('bqhmd,bkhmd->bhmqk', q, k).astype(jnp.float32) * (q.shape[-1] ** -0.5)
    p = jax.nn.softmax(sc, axis=-1)
    pd = (p[:, :, 0] - lam * p[:, :, 1]).astype(v.dtype)
    return jnp.einsum('bhqk,bkhd->bqhd', pd, v)


def sink_softmax(sc, sink_hg):
    col = jnp.broadcast_to(sink_hg.astype(jnp.float32)[:, :, None, None], sc.shape[:-1] + (1,))
    p = jax.nn.softmax(jnp.concatenate([sc, col], axis=-1), axis=-1)
    return p[..., :-1]


def ctx_sink_attend(q, k, v, sink):
    b, s, hq, d = q.shape
    hkv = k.shape[2]
    g = hq // hkv
    qg = q.reshape(b, s, hkv, g, d)
    sc = jnp.einsum('bqhgd,bkhd->bhgqk', qg, k).astype(jnp.float32) * (d ** -0.5)
    p = sink_softmax(sc, sink.reshape(hkv, g)).astype(v.dtype)
    return jnp.einsum('bhgqk,bkhd->bqhgd', p, v).reshape(b, s, hq, d)


def window_sink_attend(q, k, v, k_ctx, v_ctx, sink):
    b, s, hq, d = q.shape
    hkv = k.shape[2]
    g = hq // hkv
    t = k_ctx.shape[1]
    nb = s // Q_BLOCK
    pad = C_BAND_SIDE * Q_BLOCK
    n_band = 2 * C_BAND_SIDE + 1
    band_len = n_band * Q_BLOCK

    def band(z):
        zp = jnp.pad(z, ((0, 0), (pad, pad), (0, 0), (0, 0)))
        zb = zp.reshape(b, nb + 2 * C_BAND_SIDE, Q_BLOCK, hkv, z.shape[-1])
        return jnp.concatenate([zb[:, j:j + nb] for j in range(n_band)], axis=2)

    kb, vb = band(k), band(v)
    qb = q.reshape(b, nb, Q_BLOCK, hkv, g, d)
    blk = jnp.arange(nb)[:, None, None]
    qpos = blk * Q_BLOCK + jnp.arange(Q_BLOCK)[None, :, None]
    kpos = blk * Q_BLOCK - pad + jnp.arange(band_len)[None, None, :]
    valid = (jnp.abs(qpos - kpos) <= C_WINDOW) & (kpos >= 0) & (kpos < s)
    scale = d ** -0.5
    s_lat = jnp.einsum('bnqhgd,bnkhd->bnhgqk', qb, kb).astype(jnp.float32) * scale
    s_lat = jnp.where(valid[None, :, None, None], s_lat, NEG_INF)
    s_ctx = jnp.einsum('bnqhgd,bkhd->bnhgqk', qb, k_ctx).astype(jnp.float32) * scale
    p = sink_softmax(jnp.concatenate([s_ctx, s_lat], axis=-1), sink.reshape(hkv, g)).astype(v.dtype)
    o = (jnp.einsum('bnhgqk,bkhd->bnqhgd', p[..., :t], v_ctx)
         + jnp.einsum('bnhgqk,bnkhd->bnqhgd', p[..., t:], vb))
    return o.reshape(b, s, hq, d)


def neighbourhood_attend(q, k, v, k_ctx, v_ctx, rpb):
    b, s, h, d = q.shape
    t = k_ctx.shape[1]
    n_rows = s // GRID_W
    kh = min(NA_KH, n_rows)
    qg = q.reshape(b, n_rows, GRID_W, h, d)
    kg = k.reshape(b, n_rows, GRID_W, h, d)
    vg = v.reshape(b, n_rows, GRID_W, h, d)
    r = jnp.arange(n_rows)
    r_start = jnp.clip(r - kh // 2, 0, n_rows - kh)
    row_idx = r_start[:, None] + jnp.arange(kh)[None, :]
    k_rows = kg[:, row_idx]
    v_rows = vg[:, row_idx]
    cq = jnp.arange(GRID_W)
    c_start = jnp.clip(cq - NA_KW // 2, 0, GRID_W - NA_KW)
    col_in = (cq[None, :] >= c_start[:, None]) & (cq[None, :] < c_start[:, None] + NA_KW)
    r_off = row_idx - r[:, None] + (NA_KH - 1)
    c_off = jnp.clip(cq[None, :] - cq[:, None], -(NA_KW - 1), NA_KW - 1) + (NA_KW - 1)
    bias = rpb.astype(jnp.float32)[:, r_off[:, None, :, None], c_off[None, :, None, :]]
    scale = d ** -0.5
    s_win = jnp.einsum('brwhd,brikhd->bhrwik', qg, k_rows).astype(jnp.float32) * scale + bias[None]
    s_win = jnp.where(col_in[None, None, None, :, None, :], s_win, NEG_INF)
    s_win = s_win.reshape(b, h, n_rows, GRID_W, kh * GRID_W)
    s_ctx = jnp.einsum('brwhd,bkhd->bhrwk', qg, k_ctx).astype(jnp.float32) * scale
    p = jax.nn.softmax(jnp.concatenate([s_ctx, s_win], axis=-1), axis=-1).astype(v.dtype)
    p_win = p[..., t:].reshape(b, h, n_rows, GRID_W, kh, GRID_W)
    o = (jnp.einsum('bhrwk,bkhd->brwhd', p[..., :t], v_ctx)
         + jnp.einsum('bhrwik,brikhd->brwhd', p_win, v_rows))
    return o.reshape(b, s, h, d)


def even_layer_mixers(p, pc, rows, cols, qk_a, lam_params, subln_g, qk_b, lam_init, need_ctx):
    b, s, _ = p.shape
    t = pc.shape[1]
    aq, ak, av, bq, bk, bv = split_cols(p, EVEN_SIZES)
    caq, cak, cav, cbq, cbk, cbv = split_cols(pc, EVEN_SIZES)
    lam = (jnp.exp(jnp.sum(lam_params[0] * lam_params[1]).astype(jnp.float32))
           - jnp.exp(jnp.sum(lam_params[2] * lam_params[3]).astype(jnp.float32)) + lam_init)
    aq_l = rope_2d(rms_norm(aq.reshape(b, s, 2 * A_HEADS, A_SUB), qk_a[0]), rows, cols).reshape(b, s, A_HEADS, 2, A_SUB)
    ak_l = rope_2d(rms_norm(ak.reshape(b, s, 2 * A_HEADS, A_SUB), qk_a[1]), rows, cols).reshape(b, s, A_HEADS, 2, A_SUB)
    ak_c = rms_norm(cak.reshape(b, t, A_HEADS, 2, A_SUB), qk_a[1])
    av_c = cav.reshape(b, t, A_HEADS, HEAD_DIM)
    ka_all = jnp.concatenate([ak_c, ak_l], axis=1)
    va_all = jnp.concatenate([av_c, av.reshape(b, s, A_HEADS, HEAD_DIM)], axis=1)
    ya = sweep_query_blocks(lambda qb: diff_attend(qb, ka_all, va_all, lam), aq_l)
    ya = rms_norm(ya, subln_g) * (1.0 - lam_init)
    bq_l = rope_2d(rms_norm(bq.reshape(b, s, B_HEADS, HEAD_DIM), qk_b[0]), rows, cols)
    bk_l = rope_2d(rms_norm(bk.reshape(b, s, B_KV_HEADS, HEAD_DIM), qk_b[1]), rows, cols)
    bk_c = rms_norm(cbk.reshape(b, t, B_KV_HEADS, HEAD_DIM), qk_b[1])
    bv_c = cbv.reshape(b, t, B_KV_HEADS, HEAD_DIM)
    kb_all = jnp.concatenate([bk_c, bk_l], axis=1)
    vb_all = jnp.concatenate([bv_c, bv.reshape(b, s, B_KV_HEADS, HEAD_DIM)], axis=1)
    yb = sweep_query_blocks(lambda qb: gqa_attend(qb, kb_all, vb_all), bq_l)
    y = jnp.concatenate([ya.reshape(b, s, -1), yb.reshape(b, s, -1)], axis=-1)
    yc = None
    if need_ctx:
        aq_c = rms_norm(caq.reshape(b, t, A_HEADS, 2, A_SUB), qk_a[0])
        ya_c = rms_norm(diff_attend(aq_c, ak_c, av_c, lam), subln_g) * (1.0 - lam_init)
        bq_c = rms_norm(cbq.reshape(b, t, B_HEADS, HEAD_DIM), qk_b[0])
        yb_c = gqa_attend(bq_c, bk_c, bv_c)
        yc = jnp.concatenate([ya_c.reshape(b, t, -1), yb_c.reshape(b, t, -1)], axis=-1)
    return y, yc


def odd_layer_mixers(p, pc, rows, cols, qk_c, sink, qk_d, rpb, need_ctx):
    b, s, _ = p.shape
    t = pc.shape[1]
    cq, ck, cv, dq, dk, dv = split_cols(p, ODD_SIZES)
    ccq, cck, ccv, cdq, cdk, cdv = split_cols(pc, ODD_SIZES)
    cq_l = rope_2d(rms_norm(cq.reshape(b, s, C_HEADS, HEAD_DIM), qk_c[0]), rows, cols)
    ck_l = rope_2d(rms_norm(ck.reshape(b, s, C_KV_HEADS, HEAD_DIM), qk_c[1]), rows, cols)
    ck_c = rms_norm(cck.reshape(b, t, C_KV_HEADS, HEAD_DIM), qk_c[1])
    cv_c = ccv.reshape(b, t, C_KV_HEADS, HEAD_DIM)
    yc_lat = window_sink_attend(cq_l, ck_l, cv.reshape(b, s, C_KV_HEADS, HEAD_DIM), ck_c, cv_c, sink)
    dq_l = rms_norm(dq.reshape(b, s, D_HEADS, HEAD_DIM), qk_d[0])
    dk_l = rms_norm(dk.reshape(b, s, D_HEADS, HEAD_DIM), qk_d[1])
    dk_c = rms_norm(cdk.reshape(b, t, D_HEADS, HEAD_DIM), qk_d[1])
    dv_c = cdv.reshape(b, t, D_HEADS, HEAD_DIM)
    yd_lat = neighbourhood_attend(dq_l, dk_l, dv.reshape(b, s, D_HEADS, HEAD_DIM), dk_c, dv_c, rpb)
    y = jnp.concatenate([yc_lat.reshape(b, s, -1), yd_lat.reshape(b, s, -1)], axis=-1)
    yc = None
    if need_ctx:
        cq_c = rms_norm(ccq.reshape(b, t, C_HEADS, HEAD_DIM), qk_c[0])
        yc_c = ctx_sink_attend(cq_c, ck_c, cv_c, sink)
        dq_c = rms_norm(cdq.reshape(b, t, D_HEADS, HEAD_DIM), qk_d[0])
        yd_c = gqa_attend(dq_c, dk_c, dv_c)
        yc = jnp.concatenate([yc_c.reshape(b, t, -1), yd_c.reshape(b, t, -1)], axis=-1)
    return y, yc


def depthwise_conv(u, w, bias):
    s = u.shape[1]
    pad = CONV_W // 2
    up = jnp.pad(u, ((0, 0), (pad, pad), (0, 0)))
    out = bias + up[:, 0:s] * w[0]
    for j in range(1, CONV_W):
        out = out + up[:, j:j + s] * w[j]
    return out


def conv_ffn(h, w_up, conv_w, conv_b, w_down):
    u = depthwise_conv(h @ w_up, conv_w, conv_b)
    a, g = u[..., :D_FF], u[..., D_FF:]
    return (jax.nn.silu(g) * a) @ w_down


def lambda_init_for(layer_idx):
    return 0.8 - 0.6 * math.exp(-0.3 * layer_idx)


def setup_inputs(seed: int = 0) -> dict:
    key = jax.random.key(seed)
    ks = jax.random.split(key, 22)
    f32 = jnp.float32

    def nrm(k, shape, scale):
        return jax.random.normal(k, shape, f32) * scale

    return {
        'x': nrm(ks[0], (BATCH, SEQ, D_MODEL), 1.0),
        'c': nrm(ks[1], (BATCH, D_MODEL), 1.0),
        'ctx': nrm(ks[2], (BATCH, CTX_LEN, D_MODEL), 1.0),
        'c_ctx': nrm(ks[3], (D_MODEL,), 1.0),
        'w_ada': nrm(ks[4], (DEPTH, D_MODEL, N_MOD * D_MODEL), 0.5 * D_MODEL ** -0.5),
        'b_ada': nrm(ks[5], (DEPTH, N_MOD * D_MODEL), 0.02),
        'norm1_g': 1.0 + nrm(ks[6], (DEPTH, D_MODEL), 0.02),
        'w_in': nrm(ks[7], (DEPTH, D_MODEL, IN_WIDTH), D_MODEL ** -0.5),
        'w_out': nrm(ks[8], (DEPTH, MIX_WIDTH, D_MODEL), MIX_WIDTH ** -0.5),
        'a_qk_g': 1.0 + nrm(ks[9], (N_EVEN, 2, A_SUB), 0.02),
        'a_lambda': nrm(ks[10], (N_EVEN, 4, A_SUB), 0.1),
        'a_subln_g': 1.0 + nrm(ks[11], (N_EVEN, HEAD_DIM), 0.02),
        'b_qk_g': 1.0 + nrm(ks[12], (N_EVEN, 2, HEAD_DIM), 0.02),
        'c_qk_g': 1.0 + nrm(ks[13], (N_ODD, 2, HEAD_DIM), 0.02),
        'c_sink': nrm(ks[14], (N_ODD, C_HEADS), 0.5),
        'd_qk_g': 1.0 + nrm(ks[15], (N_ODD, 2, HEAD_DIM), 0.02),
        'd_rpb': nrm(ks[16], (N_ODD, D_HEADS, 2 * NA_KH - 1, 2 * NA_KW - 1), 0.1),
        'norm2_g': 1.0 + nrm(ks[17], (DEPTH, D_MODEL), 0.02),
        'w_up': nrm(ks[18], (DEPTH, D_MODEL, 2 * D_FF), D_MODEL ** -0.5),
        'conv_w': nrm(ks[19], (DEPTH, CONV_W, 2 * D_FF), CONV_W ** -0.5),
        'conv_b': nrm(ks[20], (DEPTH, 2 * D_FF), 0.02),
        'w_down': nrm(ks[21], (DEPTH, D_FF, D_MODEL), D_FF ** -0.5),
    }


def reference(x, c, ctx, c_ctx, w_ada, b_ada, norm1_g, w_in, w_out, a_qk_g, a_lambda, a_subln_g,
              b_qk_g, c_qk_g, c_sink, d_qk_g, d_rpb, norm2_g, w_up, conv_w, conv_b, w_down):
    s = x.shape[1]
    pos = jnp.arange(s, dtype=jnp.int32)
    rows, cols = pos // GRID_W, pos % GRID_W
    xc = ctx
    for i in range(DEPTH):
        need_ctx = i < DEPTH - 1
        mod = jax.nn.silu(c) @ w_ada[i] + b_ada[i]
        mod_c = jax.nn.silu(c_ctx) @ w_ada[i] + b_ada[i]
        sh1, sc1, g1, sh2, sc2, g2 = jnp.split(mod[:, None, :], N_MOD, axis=-1)
        csh1, csc1, cg1, csh2, csc2, cg2 = jnp.split(mod_c, N_MOD, axis=-1)
        p = modulate(rms_norm(x, norm1_g[i]), sh1, sc1) @ w_in[i]
        pc = modulate(rms_norm(xc, norm1_g[i]), csh1, csc1) @ w_in[i]
        if i % 2 == 0:
            e = i // 2
            y, yc = even_layer_mixers(p, pc, rows, cols, a_qk_g[e], a_lambda[e], a_subln_g[e],
                                      b_qk_g[e], lambda_init_for(i), need_ctx)
        else:
            o = i // 2
            y, yc = odd_layer_mixers(p, pc, rows, cols, c_qk_g[o], c_sink[o], d_qk_g[o], d_rpb[o], need_ctx)
        x = x + g1 * (y @ w_out[i])
        x = x + g2 * conv_ffn(modulate(rms_norm(x, norm2_g[i]), sh2, sc2), w_up[i], conv_w[i], conv_b[i], w_down[i])
        if need_ctx:
            xc = xc + cg1 * (yc @ w_out[i])
            xc = xc + cg2 * conv_ffn(modulate(rms_norm(xc, norm2_g[i]), csh2, csc2),
                                     w_up[i], conv_w[i], conv_b[i], w_down[i])
    return x
```

```cpp
#include <hip/hip_runtime.h>
#include <hip/hip_cooperative_groups.h>
#include <hip/hip_bf16.h>
#include <cstdio>
#include <cstdint>
#include <cmath>
namespace cg = cooperative_groups;
namespace pg8 {
#define PG8_LAS __attribute__((address_space(3)))
typedef unsigned short bf16_t;
typedef short bf16x8 __attribute__((ext_vector_type(8)));
typedef float f32x4 __attribute__((ext_vector_type(4)));
typedef unsigned u32x4 __attribute__((ext_vector_type(4)));
constexpr int BM = 256, BK = 64, HALF = 128, HTB = HALF * BK * 2  , STAGE_BYTES = 8 * HTB, NXCD = 8, WGM = 4;

__host__ __device__ __forceinline__ int lds_byte(int r, int c) { const int st = (r >> 4) * 2 + (c >> 5), rr = r & 15, cc = c & 31, ob = rr * 64 + cc * 2; return st * 1024 + (ob ^ (((ob >> 9) & 1) << 5)); }
__host__ __device__ __forceinline__ void stage_rc(int b, int& R, int& C) { const int st = b / 1024, sb = b % 1024, swz = sb ^ (((sb >> 9) & 1) << 5); R = (st >> 1) * 16 + swz / 64; C = (st & 1) * 32 + (swz % 64) / 2; }
__host__ __device__ __forceinline__ int perm32(int rho) { const int n = rho >> 4, i = rho & 15; return 8 * (i >> 2) + 4 * n + (i & 3); }

struct Unit { int pm, pn, k0; };
struct Gemm { const bf16_t* A; const bf16_t* Bt; int M, N, K, ld; };

struct StaticOrder {
    int nM, nN, nwg, G, c;
    __host__ __device__ void init(int M, int N, int G_, int c_) { nM = M / BM; nN = N / BM; nwg = nM * nN; G = G_; c = c_; }
    __host__ __device__ bool next(int i, Unit& u) const {
        const long L = (long)i * G + c; if (L >= nwg) return false;
        int wgid = (int)L; { const int q = nwg / NXCD, r = nwg % NXCD, xcd = wgid % NXCD, off = wgid / NXCD; wgid = (xcd < r ? xcd * (q + 1) : r * (q + 1) + (xcd - r) * q) + off; }
        const int nig = WGM * nN, gid = wgid / nig, fm = gid * WGM, gsz = (nM - fm) < WGM ? (nM - fm) : WGM;
        u.pm = fm + ((wgid % nig) % gsz); u.pn = (wgid % nig) / gsz; u.k0 = 0; return true;
    }
    __device__ __forceinline__ void a_ready(const Unit&) const {}
    __device__ __forceinline__ void done(const Unit&) const {}
};

__device__ __forceinline__ unsigned cvt_pk_bf16(float lo, float hi) { unsigned r; asm volatile("v_cvt_pk_bf16_f32 %0, %1, %2" : "=v"(r) : "v"(lo), "v"(hi)); return r; }
typedef float f32x2 __attribute__((ext_vector_type(2)));
__device__ __forceinline__ f32x2 gelu_pk(f32x2 v) {
    const f32x2 av = __builtin_elementwise_abs(v), d = av * 0.2316418882f + 1.0f;
    f32x2 t; t.x = __builtin_amdgcn_rcpf(d.x); t.y = __builtin_amdgcn_rcpf(d.y);
    f32x2 q = t * 0.5307027145f + (-0.7265760135f); q = q * t + 0.7107068705f; q = q * t + (-0.142248368f); q = q * t + 0.127414796f; q = q * t;
    const f32x2 s = (v * v) * (-0.72134752044f);
    f32x2 e; e.x = __builtin_amdgcn_exp2f(s.x); e.y = __builtin_amdgcn_exp2f(s.y);
    const f32x2 m = v * (q * e), r = v - m;
    f32x2 o; o.x = v.x < 0.f ? m.x : r.x; o.y = v.y < 0.f ? m.y : r.y; return o;
}

template <int ACT  > struct EpiBf16 {
    static constexpr bool PERM = true, AFTER_DRAIN = false; static_assert(ACT == 0 || ACT == 1, "EpiBf16: ACT is 0 (none) or 1 (gelu_pk)");
    bf16_t* O; int ldc; const float* bias; int split_cols; size_t split_stride; float scale0;
    __device__ __forceinline__ void operator()(const f32x4 (&acc)[2][2][4][2], const Unit& u, int wr, int wc, int fr, int fq) const {
        const int row0 = u.pm * BM + wr * 64 + fr; int colt = u.pn * BM; bf16_t* base = O;
        float sc = 1.f; if (split_cols) { const int t = colt / split_cols; base += (size_t)t * split_stride; colt -= t * split_cols; if (t == 0) sc = scale0; }
        const int col0 = colt + wc * 32 + 8 * fq, bcol0 = u.pn * BM + wc * 32 + 8 * fq;
        f32x4 bv[2][2];
#pragma unroll
        for (int bj = 0; bj < 2; ++bj)
#pragma unroll
            for (int n = 0; n < 2; ++n) bv[bj][n] = bias ? *(const f32x4*)(bias + bcol0 + bj * HALF + 4 * n) : (f32x4){0.f, 0.f, 0.f, 0.f};
#pragma unroll
        for (int ai = 0; ai < 2; ++ai)
#pragma unroll
            for (int m = 0; m < 4; ++m) { bf16_t* rowp = base + (size_t)(row0 + ai * HALF + m * 16) * ldc + col0;
#pragma unroll
                for (int bj = 0; bj < 2; ++bj) { f32x4 v0 = acc[ai][bj][m][0] + bv[bj][0], v1 = acc[ai][bj][m][1] + bv[bj][1];
                    if (ACT == 1) { f32x2 a = gelu_pk((f32x2){v0[0], v0[1]}), b = gelu_pk((f32x2){v0[2], v0[3]}), c = gelu_pk((f32x2){v1[0], v1[1]}), d = gelu_pk((f32x2){v1[2], v1[3]});
                        v0 = (f32x4){a.x, a.y, b.x, b.y}; v1 = (f32x4){c.x, c.y, d.x, d.y}; }
                    v0 = v0 * sc; v1 = v1 * sc; u32x4 w; w.x = cvt_pk_bf16(v0[0], v0[1]); w.y = cvt_pk_bf16(v0[2], v0[3]); w.z = cvt_pk_bf16(v1[0], v1[1]); w.w = cvt_pk_bf16(v1[2], v1[3]);
                    *(u32x4*)(rowp + bj * HALF) = w; } }
    }
};
typedef unsigned u32x2_t __attribute__((ext_vector_type(2)));
struct EpiGateRes {
    static constexpr bool PERM = false, AFTER_DRAIN = false;
    const float* base_ctx; const float* base_lat; float* out; const float* gate_ctx; const float* gate_lat; int row_off;
    __device__ __forceinline__ void operator()(const f32x4 (&acc)[2][2][4][2], const Unit& u, int wr, int wc, int fr, int fq) const {
        const int grow0 = row_off + u.pm * BM; const bool isctx = grow0 < 256;
        const float* base = isctx ? base_ctx : base_lat; const float* gate = isctx ? gate_ctx : gate_lat;
        const int col0 = u.pn * BM + wc * 32 + 4 * fq;
        f32x4 gv[2][2];
#pragma unroll
        for (int bj = 0; bj < 2; ++bj)
#pragma unroll
            for (int n = 0; n < 2; ++n) gv[bj][n] = *(const f32x4*)(gate + col0 + bj * HALF + n * 16);
#pragma unroll
        for (int ai = 0; ai < 2; ++ai)
#pragma unroll
            for (int m = 0; m < 4; ++m) { const size_t off = (size_t)(grow0 + ai * HALF + wr * 64 + m * 16 + fr) * 2048 + col0;
#pragma unroll
                for (int bj = 0; bj < 2; ++bj)
#pragma unroll
                    for (int n = 0; n < 2; ++n) { const f32x4 b = *(const f32x4*)(base + off + bj * HALF + n * 16);
                        *(f32x4*)(out + off + bj * HALF + n * 16) = b + gv[bj][n] * acc[ai][bj][m][n]; }
                if (m & 1) asm volatile("" ::: "memory"); }
    }
};
struct SplitKOrder {
    int nN, nsub, ksub, G, c;
    __device__ bool next(int i, Unit& u) const { const int L = i * G + c; if (L >= nsub) return false; u.pm = 0; u.pn = L % nN; u.k0 = (L / nN) * ksub; return true; }
    __device__ __forceinline__ void a_ready(const Unit&) const {}
    __device__ __forceinline__ void done(const Unit&) const {}
};
struct EpiGateAtomic {
    static constexpr bool PERM = false, AFTER_DRAIN = false;
    float* out; const float* gate;
    __device__ __forceinline__ void operator()(const f32x4 (&acc)[2][2][4][2], const Unit& u, int wr, int wc, int fr, int fq) const {
        const int col0 = u.pn * BM + wc * 32 + 4 * fq;
#pragma unroll
        for (int bj = 0; bj < 2; ++bj)
#pragma unroll
            for (int n = 0; n < 2; ++n) { const f32x4 gv = *(const f32x4*)(gate + col0 + bj * HALF + n * 16);
#pragma unroll
                for (int ai = 0; ai < 2; ++ai)
#pragma unroll
                    for (int m = 0; m < 4; ++m) { float* o = out + (size_t)(ai * HALF + wr * 64 + m * 16 + fr) * 2048 + col0 + bj * HALF + n * 16; const f32x4 v = gv * acc[ai][bj][m][n];
                        __hip_atomic_fetch_add(o + 0, v.x, __ATOMIC_RELAXED, __HIP_MEMORY_SCOPE_AGENT); __hip_atomic_fetch_add(o + 1, v.y, __ATOMIC_RELAXED, __HIP_MEMORY_SCOPE_AGENT);
                        __hip_atomic_fetch_add(o + 2, v.z, __ATOMIC_RELAXED, __HIP_MEMORY_SCOPE_AGENT); __hip_atomic_fetch_add(o + 3, v.w, __ATOMIC_RELAXED, __HIP_MEMORY_SCOPE_AGENT); } }
    }
};
struct EpiConvGate {
    static constexpr bool PERM = true, AFTER_DRAIN = false;
    bf16_t* A2; bf16_t* U; const float* cw; const float* cb; int row_off;
    __device__ __forceinline__ void operator()(const f32x4 (&acc)[2][2][4][2], const Unit& u, int wr, int wc, int fr, int fq) const {
        const int lane = fq * 16 + fr;
        const int src_prev = fr > 0 ? lane - 1 : lane + 15, src_next = fr < 15 ? lane + 1 : lane - 15;
        const int ch0 = u.pn * 128 + wc * 32 + 8 * fq;
        const size_t urow0 = (size_t)row_off + (size_t)u.pm * BM + wr * 64 + fr;
#pragma unroll
        for (int n = 0; n < 2; ++n) {
            const int ch = ch0 + 4 * n;
            const f32x4 wa0 = *(const f32x4*)(cw + ch), wa1 = *(const f32x4*)(cw + 11264 + ch), wa2 = *(const f32x4*)(cw + 2 * 11264 + ch), ba = *(const f32x4*)(cb + ch);
            const f32x4 wg0 = *(const f32x4*)(cw + 5632 + ch), wg1 = *(const f32x4*)(cw + 11264 + 5632 + ch), wg2 = *(const f32x4*)(cw + 2 * 11264 + 5632 + ch), bg = *(const f32x4*)(cb + 5632 + ch);
#pragma unroll
            for (int ai = 0; ai < 2; ++ai)
#pragma unroll
                for (int m = 0; m < 4; ++m) {
                    const f32x4 ca = acc[ai][0][m][n], cg = acc[ai][1][m][n];
                    const f32x4 pa_src = (m > 0 && fr == 15) ? acc[ai][0][m > 0 ? m - 1 : 0][n] : ca, pg_src = (m > 0 && fr == 15) ? acc[ai][1][m > 0 ? m - 1 : 0][n] : cg;
                    const f32x4 na_src = (m < 3 && fr == 0) ? acc[ai][0][m < 3 ? m + 1 : 3][n] : ca, ng_src = (m < 3 && fr == 0) ? acc[ai][1][m < 3 ? m + 1 : 3][n] : cg;
                    f32x4 pa, pg, na, ng;
#pragma unroll
                    for (int e = 0; e < 4; ++e) { pa[e] = __shfl(pa_src[e], src_prev); pg[e] = __shfl(pg_src[e], src_prev); na[e] = __shfl(na_src[e], src_next); ng[e] = __shfl(ng_src[e], src_next); }
                    const size_t ur = urow0 + ai * HALF + m * 16;
                    const bool deferred = (m == 0 && fr == 0) || (m == 3 && fr == 15);
                    const bool raw = (m == 0 && fr <= 1) || (m == 3 && fr >= 14);
                    if (raw) { u32x2_t w; w.x = cvt_pk_bf16(ca[0], ca[1]); w.y = cvt_pk_bf16(ca[2], ca[3]); *(u32x2_t*)(U + ur * 11264 + ch) = w;
                               w.x = cvt_pk_bf16(cg[0], cg[1]); w.y = cvt_pk_bf16(cg[2], cg[3]); *(u32x2_t*)(U + ur * 11264 + 5632 + ch) = w; }
                    if (!deferred) {
                        const f32x4 oa = ba + pa * wa0 + ca * wa1 + na * wa2, og = bg + pg * wg0 + cg * wg1 + ng * wg2;
                        f32x4 y;
#pragma unroll
                        for (int e = 0; e < 4; ++e) y[e] = og[e] * __builtin_amdgcn_rcpf(1.f + __expf(-og[e])) * oa[e];
                        u32x2_t w; w.x = cvt_pk_bf16(y[0], y[1]); w.y = cvt_pk_bf16(y[2], y[3]);
                        *(u32x2_t*)(A2 + ur * 5632 + ch) = w;
                    }
                }
        }
    }
};
template <int LAYER> struct EpiQKV {
    static constexpr bool PERM = true, AFTER_DRAIN = false;
    bf16_t* P; const float* gtab; PG8_LAS float* part;
    __device__ __forceinline__ void operator()(const f32x4 (&acc)[2][2][4][2], const Unit& u, int wr, int wc, int fr, int fq) const {
        const int pn = u.pn;
        bool plain, w64, rope; const float* g;
        if (LAYER == 0) { plain = (pn >= 8 && pn < 12) || pn == 17; w64 = pn < 8; rope = true; g = gtab + (pn < 4 ? 0 : 64) + (pn < 8 ? 0 : 64) + (pn < 16 ? 0 : 128); }
        else            { plain = pn == 5 || pn >= 14; w64 = false; rope = pn < 5; g = gtab + (pn < 4 ? 0 : 128) + (pn < 5 ? 0 : 128) + (pn < 10 ? 0 : 128); }
        const int row0 = u.pm * BM + wr * 64 + fr, colw = wc * 32 + 8 * fq;
        bf16_t* base = P + (size_t)row0 * 4608 + (size_t)pn * BM + colw;
        if (plain) {
#pragma unroll
            for (int ai = 0; ai < 2; ++ai)
#pragma unroll
                for (int m = 0; m < 4; ++m)
#pragma unroll
                    for (int bj = 0; bj < 2; ++bj) { const f32x4 v0 = acc[ai][bj][m][0], v1 = acc[ai][bj][m][1];
                        u32x4 w; w.x = cvt_pk_bf16(v0[0], v0[1]); w.y = cvt_pk_bf16(v0[2], v0[3]); w.z = cvt_pk_bf16(v1[0], v1[1]); w.w = cvt_pk_bf16(v1[2], v1[3]);
                        *(u32x4*)(base + (size_t)(ai * HALF + m * 16) * 4608 + bj * HALF) = w; }
            return;
        }
        const bool latent = u.pm > 0;
        PG8_LAS float* pw = part + (wr * 64 + fr) * 8 + wc; const PG8_LAS float* prd = part + (wr * 64 + fr) * 8;
#pragma unroll
        for (int ai = 0; ai < 2; ++ai)
#pragma unroll
            for (int m = 0; m < 4; ++m)
#pragma unroll
                for (int bj = 0; bj < 2; ++bj) { const f32x4 v0 = acc[ai][bj][m][0], v1 = acc[ai][bj][m][1];
                    float s = (v0[0] * v0[0] + v0[1] * v0[1]) + (v0[2] * v0[2] + v0[3] * v0[3]) + (v1[0] * v1[0] + v1[1] * v1[1]) + (v1[2] * v1[2] + v1[3] * v1[3]);
                    s += __shfl_xor(s, 16); s += __shfl_xor(s, 32);
                    if (fq == 0) pw[(ai * HALF + m * 16) * 8 + bj * 4] = s; }
        asm volatile("s_waitcnt lgkmcnt(0)" ::: "memory"); __builtin_amdgcn_s_barrier(); asm volatile("" ::: "memory");
        const int jh = w64 ? ((wc & 1) * 32 + 8 * fq) : colw;
        int dh = jh;
        if (!w64 && rope) { const int b = jh >> 4, bo = (b == 1 || b == 5) ? b + 1 : (b == 2 || b == 6) ? b - 1 : b; dh = bo * 16 + (jh & 15); }
        const f32x4 ga = *(const f32x4*)(g + dh), gb = *(const f32x4*)(g + dh + 4);
        const float gg[8] = {ga[0], ga[1], ga[2], ga[3], gb[0], gb[1], gb[2], gb[3]};
        const bool first = fq < 2;
        const bool colpos = w64 ? (wc & 1) : (wc >> 1);
        float fr8[8];
        { const int i0 = (w64 ? 0 : 16 * (wc & 1)) + 8 * (fq & 1); const float fstep = w64 ? (-13.287712379549449f / 16.f) : (-13.287712379549449f / 32.f);
#pragma unroll
          for (int e8 = 0; e8 < 8; ++e8) fr8[e8] = __builtin_amdgcn_exp2f((float)(i0 + e8) * fstep); }
        const float invw = w64 ? (1.f / 64.f) : (1.f / 128.f);
#pragma unroll
        for (int ai = 0; ai < 2; ++ai)
#pragma unroll
            for (int m = 0; m < 4; ++m) {
                const int rl = ai * HALF + wr * 64 + m * 16 + fr;
                const int tpos = u.pm * BM + rl - 256;
                const float pos = (float)(colpos ? (tpos & 63) : (tpos >> 6));
#pragma unroll
                for (int bj = 0; bj < 2; ++bj) {
                    const PG8_LAS float* pp = prd + (ai * HALF + m * 16) * 8 + bj * 4;
                    const float ssum = w64 ? (pp[wc & 2] + pp[(wc & 2) + 1]) : ((pp[0] + pp[1]) + (pp[2] + pp[3]));
                    const float rstd = __builtin_amdgcn_rsqf(ssum * invw + 1e-6f);
                    const f32x4 v0 = acc[ai][bj][m][0], v1 = acc[ai][bj][m][1];
                    float x[8] = {v0[0], v0[1], v0[2], v0[3], v1[0], v1[1], v1[2], v1[3]};
#pragma unroll
                    for (int e8 = 0; e8 < 8; ++e8) x[e8] = x[e8] * rstd * gg[e8];
                    if (rope) {
#pragma unroll
                        for (int e8 = 0; e8 < 8; ++e8) { const float other = __shfl_xor(x[e8], 32);
                            const float ang = pos * fr8[e8]; const float cs = __cosf(ang), sn = __sinf(ang);
                            const float rot = first ? x[e8] * cs - other * sn : x[e8] * cs + other * sn;
                            x[e8] = latent ? rot : x[e8]; }
                    }
                    u32x4 w; w.x = cvt_pk_bf16(x[0], x[1]); w.y = cvt_pk_bf16(x[2], x[3]); w.z = cvt_pk_bf16(x[4], x[5]); w.w = cvt_pk_bf16(x[6], x[7]);
                    *(u32x4*)(base + (size_t)(ai * HALF + m * 16) * 4608 + bj * HALF) = w;
                    asm volatile("" ::: "memory");
                }
            }
    }
};
template <class Epi, class Sched, bool ALIGN_EPI = false, bool SP2 = false>
__device__ __forceinline__ void gemm_phase(PG8_LAS unsigned char* lds, const Gemm g, const Sched& S, const Epi& E) {
    int tid_ = threadIdx.x; asm volatile("" : "+v"(tid_)); const int tid = tid_, wid = __builtin_amdgcn_readfirstlane(tid >> 6), lane = tid & 63, wr = wid >> 2, wc = wid & 3, fr = lane & 15, fq = lane >> 4;
    const int K = g.ld, nt = g.K / BK;
    unsigned voffA[2], voffB[2];
#pragma unroll
    for (int i = 0; i < 2; ++i) { int R, C; stage_rc(tid * 16 + i * 8192, R, C); const int Rb = Epi::PERM ? ((R & ~31) + perm32(R & 31)) : R;
        voffA[i] = (unsigned)(R * K + C) * 2u; voffB[i] = (unsigned)(Rb * K + C) * 2u; }
    const size_t kstep = (size_t)(BK * 2);
    const size_t hstep = (size_t)HALF * K * 2;
    const size_t tstep = 2 * hstep;
    const unsigned ldsw = (unsigned)wid * 1024u;
    const int aoff = lds_byte(wr * 64 + fr, fq * 8), boff = lds_byte(wc * 32 + fr, fq * 8);
#define PG8_SA(b, h) (((b) * 2 + (h)) * HTB)
#define PG8_SB(b, h) ((4 + (b) * 2 + (h)) * HTB)
#define PG8_STAGE(bufoff, gbase, voff) do { _Pragma("unroll") for (int _i = 0; _i < 2; ++_i) \
        __builtin_amdgcn_global_load_lds((const unsigned*)((const char*)(gbase) + (voff)[_i]), (PG8_LAS unsigned*)(lds + (bufoff) + ldsw + _i * 8192), 16, 0, 0); } while (0)
#define PG8_LDA(dst, b, h) do { _Pragma("unroll") for (int m = 0; m < 4; ++m) _Pragma("unroll") for (int k = 0; k < 2; ++k) dst[m][k] = *(const PG8_LAS bf16x8*)(lds + PG8_SA(b, h) + aoff + m * 2048 + k * 1024); } while (0)
#define PG8_LDB(dst, b, h) do { _Pragma("unroll") for (int n = 0; n < 2; ++n) _Pragma("unroll") for (int k = 0; k < 2; ++k) dst[n][k] = *(const PG8_LAS bf16x8*)(lds + PG8_SB(b, h) + boff + n * 2048 + k * 1024); } while (0)
#define PG8_MMA(ai, bj, At, Bt) do { __builtin_amdgcn_s_setprio(1); _Pragma("unroll") for (int m = 0; m < 4; ++m) _Pragma("unroll") for (int n = 0; n < 2; ++n) _Pragma("unroll") for (int k = 0; k < 2; ++k) \
        acc[ai][bj][m][n] = __builtin_amdgcn_mfma_f32_16x16x32_bf16(Bt[n][k], At[m][k], acc[ai][bj][m][n], 0, 0, 0); __builtin_amdgcn_s_setprio(0); } while (0)
#define PG8_WAIT_V(n) asm volatile("s_waitcnt vmcnt(" #n ")" ::: "memory")
#define PG8_WAIT_L(n) asm volatile("s_waitcnt lgkmcnt(" #n ")" ::: "memory")
#define PG8_BAR __builtin_amdgcn_s_barrier()
#define PG8_SCHED __builtin_amdgcn_sched_barrier(0)
    Unit cur, nxt; int ui = 0;
    if (!S.next(0, cur)) return;
    f32x4 acc[2][2][4][2];
#pragma unroll
    for (int a = 0; a < 2; ++a)
#pragma unroll
        for (int b = 0; b < 2; ++b)
#pragma unroll
            for (int m = 0; m < 4; ++m)
#pragma unroll
                for (int n = 0; n < 2; ++n) acc[a][b][m][n] = (f32x4){0.f, 0.f, 0.f, 0.f};
    bf16x8 At[4][2], B0[2][2], B1[2][2];
    const char* cA = (const char*)g.A + (size_t)cur.pm * tstep + (size_t)cur.k0 * 2; const char* cB = (const char*)g.Bt + (size_t)cur.pn * tstep + (size_t)cur.k0 * 2;
    S.a_ready(cur);
    if constexpr (SP2) {
        PG8_STAGE(PG8_SB(0, 0), cB, voffB); PG8_STAGE(PG8_SB(0, 1), cB + hstep, voffB); PG8_STAGE(PG8_SA(0, 0), cA, voffA); PG8_STAGE(PG8_SA(0, 1), cA + hstep, voffA);
        if (wr == 1) PG8_BAR;
        PG8_WAIT_V(2); PG8_BAR;
        PG8_STAGE(PG8_SB(1, 0), cB + kstep, voffB); PG8_STAGE(PG8_SA(1, 0), cA + kstep, voffA); PG8_STAGE(PG8_SB(1, 1), cB + hstep + kstep, voffB);
        PG8_WAIT_V(6); PG8_BAR;
    } else {
        PG8_STAGE(PG8_SB(0, 0), cB, voffB); PG8_STAGE(PG8_SA(0, 0), cA, voffA); PG8_STAGE(PG8_SB(0, 1), cB + hstep, voffB); PG8_STAGE(PG8_SA(0, 1), cA + hstep, voffA);
        if (wr == 1) PG8_BAR;
        PG8_WAIT_V(4); PG8_BAR;
        PG8_STAGE(PG8_SB(1, 0), cB + kstep, voffB); PG8_STAGE(PG8_SA(1, 0), cA + kstep, voffA); PG8_STAGE(PG8_SB(1, 1), cB + hstep + kstep, voffB);
        PG8_WAIT_V(6); PG8_BAR;
    }
    for (;;) {
        const bool has_next = S.next(ui + 1, nxt);
        const char* nA = has_next ? (const char*)g.A + (size_t)nxt.pm * tstep + (size_t)nxt.k0 * 2 : cA; const char* nB = has_next ? (const char*)g.Bt + (size_t)nxt.pn * tstep + (size_t)nxt.k0 * 2 : cB;
        for (int t = 0; t < nt; t += 2) {
            const bool last = (t == nt - 2);
            const char* a1 = cA + (size_t)(t + 1) * kstep;
            const char* a2 = last ? nA : cA + (size_t)(t + 2) * kstep; const char* b2 = last ? nB : cB + (size_t)(t + 2) * kstep;
            const char* a3 = a2 + kstep; const char* b3 = b2 + kstep;
            if (last && has_next) S.a_ready(nxt);
            if constexpr (SP2) {
            PG8_LDB(B0, 0, 0); PG8_LDB(B1, 0, 1); PG8_SCHED; PG8_LDA(At, 0, 0); PG8_STAGE(PG8_SA(1, 1), a1 + hstep, voffA);
            PG8_WAIT_V(8); PG8_WAIT_L(0); PG8_BAR; PG8_MMA(0, 0, At, B0); PG8_MMA(0, 1, At, B1); PG8_BAR; PG8_SCHED;
            PG8_LDA(At, 0, 1); PG8_STAGE(PG8_SB(0, 0), b2, voffB); PG8_STAGE(PG8_SB(0, 1), b2 + hstep, voffB); PG8_STAGE(PG8_SA(0, 0), a2, voffA);
            PG8_WAIT_V(8); PG8_WAIT_L(0); PG8_BAR; PG8_MMA(1, 0, At, B0); PG8_MMA(1, 1, At, B1); PG8_BAR; PG8_SCHED;
            PG8_LDB(B0, 1, 0); PG8_LDB(B1, 1, 1); PG8_SCHED; PG8_LDA(At, 1, 0); PG8_STAGE(PG8_SA(0, 1), a2 + hstep, voffA);
            PG8_WAIT_V(8); PG8_WAIT_L(0); PG8_BAR; PG8_MMA(0, 0, At, B0); PG8_MMA(0, 1, At, B1); PG8_BAR; PG8_SCHED;
            PG8_LDA(At, 1, 1); PG8_STAGE(PG8_SB(1, 0), b3, voffB); PG8_STAGE(PG8_SB(1, 1), b3 + hstep, voffB); PG8_STAGE(PG8_SA(1, 0), a3, voffA);
            PG8_WAIT_V(8); PG8_WAIT_L(0); PG8_BAR; PG8_MMA(1, 0, At, B0); PG8_MMA(1, 1, At, B1); PG8_BAR; PG8_SCHED;
            } else {
            PG8_LDB(B0, 0, 0); PG8_SCHED; PG8_LDA(At, 0, 0); PG8_STAGE(PG8_SA(1, 1), a1 + hstep, voffA);
            PG8_WAIT_L(8); PG8_BAR; PG8_WAIT_L(0); PG8_MMA(0, 0, At, B0); PG8_BAR; PG8_SCHED;
            PG8_LDB(B1, 0, 1); PG8_STAGE(PG8_SB(0, 0), b2, voffB);
            PG8_BAR; PG8_WAIT_L(0); PG8_MMA(0, 1, At, B1); PG8_BAR;
            PG8_LDA(At, 0, 1); PG8_STAGE(PG8_SA(0, 0), a2, voffA);
            PG8_BAR; PG8_WAIT_L(0); PG8_MMA(1, 0, At, B0); PG8_BAR; PG8_SCHED;
            PG8_STAGE(PG8_SB(0, 1), b2 + hstep, voffB);
            PG8_WAIT_V(6); PG8_BAR; PG8_MMA(1, 1, At, B1); PG8_BAR;
            PG8_LDB(B0, 1, 0); PG8_SCHED; PG8_LDA(At, 1, 0); PG8_STAGE(PG8_SA(0, 1), a2 + hstep, voffA);
            PG8_WAIT_L(8); PG8_BAR; PG8_WAIT_L(0); PG8_MMA(0, 0, At, B0); PG8_BAR; PG8_SCHED;
            PG8_LDB(B1, 1, 1); PG8_STAGE(PG8_SB(1, 0), b3, voffB);
            PG8_BAR; PG8_WAIT_L(0); PG8_MMA(0, 1, At, B1); PG8_BAR;
            PG8_LDA(At, 1, 1); PG8_STAGE(PG8_SA(1, 0), a3, voffA);
            PG8_BAR; PG8_WAIT_L(0); PG8_MMA(1, 0, At, B0); PG8_BAR; PG8_SCHED;
            PG8_STAGE(PG8_SB(1, 1), b3 + hstep, voffB);
            PG8_WAIT_V(6); PG8_BAR; PG8_MMA(1, 1, At, B1); PG8_BAR;
            }
        }
        if constexpr (ALIGN_EPI) { if (wr == 0) PG8_BAR; }
        if constexpr (!Epi::AFTER_DRAIN) { E(acc, cur, wr, wc, fr, fq); S.done(cur); }
        if (!has_next) break;
#pragma unroll
        for (int a = 0; a < 2; ++a)
#pragma unroll
            for (int b = 0; b < 2; ++b)
#pragma unroll
                for (int m = 0; m < 4; ++m)
#pragma unroll
                    for (int n = 0; n < 2; ++n) acc[a][b][m][n] = (f32x4){0.f, 0.f, 0.f, 0.f};
        cur = nxt; cA = nA; cB = nB; ++ui;
        if constexpr (ALIGN_EPI) { if (wr == 1) PG8_BAR; }
    }
    PG8_WAIT_V(0);
    if constexpr (!ALIGN_EPI) { if (wr == 0) PG8_BAR; }
    PG8_BAR;
    if constexpr (Epi::AFTER_DRAIN) { E.fused(acc, cur, wr, wc, fr, fq, lds, wid, lane); S.done(cur); }
#undef PG8_SA
#undef PG8_SB
#undef PG8_STAGE
#undef PG8_LDA
#undef PG8_LDB
#undef PG8_MMA
#undef PG8_WAIT_V
#undef PG8_WAIT_L
#undef PG8_BAR
#undef PG8_SCHED
}
}
namespace att {
using bf16 = __hip_bfloat16;
using bf16x8 = __attribute__((ext_vector_type(8))) short;
using s16x4  = __attribute__((ext_vector_type(4))) short;
using f32x16 = __attribute__((ext_vector_type(16))) float;
using u32x4  = __attribute__((ext_vector_type(4))) unsigned;
constexpr int LDP = 4608;
constexpr int LDY = 2048;
constexpr int SHM_V = 64 * 128 * 2, SHM_K = 64 * 128 * 2;
constexpr int NSLOT = 3;
constexpr int OFF_Q = 2 * SHM_V + 2 * SHM_K;
constexpr int OFF_WS = 131072, OFF_TAB = OFF_WS + 8 * 64 * 4, ATT_LDS = OFF_TAB + 2048;
constexpr float THR = 8.f;


#define SBAR() __builtin_amdgcn_sched_barrier(0)
__device__ __forceinline__ int crow(int r, int hi) { return (r & 3) + 8 * (r >> 2) + 4 * hi; }
__device__ __forceinline__ unsigned cvtpk(float lo, float hi) { unsigned r; asm volatile("v_cvt_pk_bf16_f32 %0, %1, %2" : "=v"(r) : "v"(lo), "v"(hi)); return r; }
__device__ __forceinline__ bf16x8 ld8(const bf16* p) { return *reinterpret_cast<const bf16x8*>(p); }
template <int DQK> __device__ __forceinline__ int kswz(int row, int colB) {
  if constexpr (DQK == 128) return row * 256 + (colB ^ ((((row & 7) | (((row >> 4) & 1) << 3))) << 4));
  else return row * 128 + (colB ^ (((((row >> 1) & 3) | (((row >> 4) & 1) << 2))) << 4));
}

template <int DQK> __device__ __forceinline__ void partialSM(f32x16& p0, f32x16& p1, float& m_reg, float& mn, float& alpha) {
  constexpr float SCALE = (DQK == 128) ? 0.088388347648318440f : 0.125f;
  constexpr float C = SCALE * 1.4426950408889634f;
  float pmax = p0[0];
#pragma unroll
  for (int r = 1; r < 16; ++r) pmax = fmaxf(pmax, p0[r]);
#pragma unroll
  for (int r = 0; r < 16; ++r) pmax = fmaxf(pmax, p1[r]);
  { auto rr = __builtin_amdgcn_permlane32_swap(__float_as_uint(pmax), __float_as_uint(pmax), false, false);
    pmax = fmaxf(__uint_as_float(rr[0]), __uint_as_float(rr[1])); }
  if (__builtin_expect(__all(pmax - m_reg <= THR / SCALE), 1)) { mn = m_reg; alpha = 1.f; }
  else { mn = fmaxf(m_reg, pmax); alpha = __builtin_amdgcn_exp2f((m_reg - mn) * C); m_reg = mn; }
  float mnC = -mn * C;
#pragma unroll
  for (int r = 0; r < 16; ++r) p0[r] = fmaf(p0[r], C, mnC);
#pragma unroll
  for (int r = 0; r < 16; ++r) p1[r] = fmaf(p1[r], C, mnC);
#pragma unroll
  for (int r = 0; r < 16; ++r) p0[r] = __builtin_amdgcn_exp2f(p0[r]);
}
__device__ __forceinline__ void finishSM(f32x16& p0, f32x16& p1, float alpha, float& l_reg, bf16x8& pa0, bf16x8& pa1, bf16x8& pa2, bf16x8& pa3) {
#pragma unroll
  for (int r = 0; r < 16; ++r) p1[r] = __builtin_amdgcn_exp2f(p1[r]);
  float ps = 0;
#pragma unroll
  for (int r = 0; r < 16; ++r) ps += p0[r];
#pragma unroll
  for (int r = 0; r < 16; ++r) ps += p1[r];
  { auto rr = __builtin_amdgcn_permlane32_swap(__float_as_uint(ps), __float_as_uint(ps), false, false);
    ps = __uint_as_float(rr[0]) + __uint_as_float(rr[1]); }
  l_reg = l_reg * alpha + ps;
#define PK4(P, BASE, OUT) do { unsigned a0 = cvtpk(P[BASE + 0], P[BASE + 1]), a1 = cvtpk(P[BASE + 2], P[BASE + 3]);   \
    unsigned b0 = cvtpk(P[BASE + 4], P[BASE + 5]), b1 = cvtpk(P[BASE + 6], P[BASE + 7]);                              \
    auto r0 = __builtin_amdgcn_permlane32_swap(a0, b0, false, false); auto r1 = __builtin_amdgcn_permlane32_swap(a1, b1, false, false); \
    u32x4 w = {r0[0], r1[0], r0[1], r1[1]}; OUT = *reinterpret_cast<bf16x8*>(&w); } while (0)
  PK4(p0, 0, pa0); PK4(p0, 8, pa1); PK4(p1, 0, pa2); PK4(p1, 8, pa3);
#undef PK4
}
template <int DQK, bool QREG> __device__ __forceinline__ void qkt(f32x16& p0, f32x16& p1, const bf16* Ks, const bf16x8* qr, const char* Qimg, int r32, int hi) {
  p0 = f32x16{}; p1 = f32x16{};
#pragma unroll
  for (int d0 = 0; d0 < DQK / 16; ++d0) { int cb = (d0 * 16 + hi * 8) * 2;
    bf16x8 q; if constexpr (QREG) q = qr[d0]; else q = *reinterpret_cast<const bf16x8*>(Qimg + d0 * 1024);
    bf16x8 b0 = *reinterpret_cast<const bf16x8*>((const char*)Ks + kswz<DQK>(r32, cb));
    bf16x8 b1 = *reinterpret_cast<const bf16x8*>((const char*)Ks + kswz<DQK>(32 + r32, cb));
    p0 = __builtin_amdgcn_mfma_f32_32x32x16_bf16(b0, q, p0, 0, 0, 0);
    p1 = __builtin_amdgcn_mfma_f32_32x32x16_bf16(b1, q, p1, 0, 0, 0); }
}
__device__ __forceinline__ int v_st(int k, int c) { const int kk = (k & ~0xC) | ((k & 4) << 1) | ((k & 8) >> 1); return ((kk >> 3) * 4 + (c >> 5)) * 512 + ((kk & 7) * 32 + (c & 31)) * 2; }
__device__ __forceinline__ int v_rd_base(int lane) { return ((lane & 3) << 3) | (((lane >> 2) & 3) << 6) | (((lane >> 4) & 1) << 5) | (((lane >> 5) & 1) << 8); }
constexpr int v_rd_off(int d0, int ks, int half) { return d0 * 512 + ks * 4096 + half * 2048; }
template <int OFF> __device__ __forceinline__ s16x4 tr_read(int vb) {
  s16x4 r; asm volatile("ds_read_b64_tr_b16 %0, %1 offset:%2" : "=&v"(r) : "v"(vb), "i"(OFF) : "memory"); return r;
}
template <int D0> __device__ __forceinline__ void pv_one(f32x16& od, int vb, bf16x8 pa0, bf16x8 pa1, bf16x8 pa2, bf16x8 pa3) {
  const s16x4 l0 = tr_read<v_rd_off(D0, 0, 0)>(vb), h0 = tr_read<v_rd_off(D0, 0, 1)>(vb), l1 = tr_read<v_rd_off(D0, 1, 0)>(vb), h1 = tr_read<v_rd_off(D0, 1, 1)>(vb);
  const s16x4 l2 = tr_read<v_rd_off(D0, 2, 0)>(vb), h2 = tr_read<v_rd_off(D0, 2, 1)>(vb), l3 = tr_read<v_rd_off(D0, 3, 0)>(vb), h3 = tr_read<v_rd_off(D0, 3, 1)>(vb);
  asm volatile("s_waitcnt lgkmcnt(0)" ::: "memory"); SBAR();
#define PK(L, H) (bf16x8){L[0], L[1], L[2], L[3], H[0], H[1], H[2], H[3]}
  od = __builtin_amdgcn_mfma_f32_32x32x16_bf16(pa0, PK(l0, h0), od, 0, 0, 0);
  od = __builtin_amdgcn_mfma_f32_32x32x16_bf16(pa1, PK(l1, h1), od, 0, 0, 0);
  od = __builtin_amdgcn_mfma_f32_32x32x16_bf16(pa2, PK(l2, h2), od, 0, 0, 0);
  od = __builtin_amdgcn_mfma_f32_32x32x16_bf16(pa3, PK(l3, h3), od, 0, 0, 0);
#undef PK
}
__device__ __forceinline__ void pv_d0(f32x16* o, int vb, bf16x8 pa0, bf16x8 pa1, bf16x8 pa2, bf16x8 pa3) {
  pv_one<0>(o[0], vb, pa0, pa1, pa2, pa3); pv_one<1>(o[1], vb, pa0, pa1, pa2, pa3); pv_one<2>(o[2], vb, pa0, pa1, pa2, pa3); pv_one<3>(o[3], vb, pa0, pa1, pa2, pa3);
}

struct MaskCtx { int a, b, c; const float* tab; };
template <int MODE> __device__ __forceinline__ void apply_mask(f32x16& p0, f32x16& p1, int j, const MaskCtx& mc, int hi) {
  if constexpr (MODE == 0) return;
  if (j < 4) return;
  if constexpr (MODE == 1) {
    const int kt0 = mc.b + (j - 4) * 64;
#pragma unroll
    for (int r = 0; r < 16; ++r) {
      const int k0 = kt0 + crow(r, hi), k1 = k0 + 32;
      const int d0 = mc.a - k0, d1 = mc.a - k1;
      const bool v0 = (d0 <= 128) && (d0 >= -128) && (k0 >= 0) && (k0 < 8192);
      const bool v1 = (d1 <= 128) && (d1 >= -128) && (k1 >= 0) && (k1 < 8192);
      p0[r] = v0 ? p0[r] : -1e30f; p1[r] = v1 ? p1[r] : -1e30f;
    }
  } else if constexpr (MODE == 2) {
    const int kr = mc.c + (j - 4);
    const int rs = min(max(mc.a - 4, 0), 120);
    const bool rv = (kr >= rs) && (kr < rs + 8);
    const int cs = min(max(mc.b - 8, 0), 48);
    const int tb = (rv ? (kr - mc.a + 7) : 7) * 31 - mc.b + 15;
#pragma unroll
    for (int r = 0; r < 16; ++r) {
      const int c0 = crow(r, hi), c1 = c0 + 32;
      const bool v0 = rv && (c0 >= cs) && (c0 < cs + 16);
      const bool v1 = rv && (c1 >= cs) && (c1 < cs + 16);
      const float b0 = mc.tab[v0 ? tb + c0 : 0], b1 = mc.tab[v1 ? tb + c1 : 0];
      p0[r] = v0 ? p0[r] + b0 : -1e30f; p1[r] = v1 ? p1[r] + b1 : -1e30f;
    }
  }
}

template <int DQK, int MODE>
__device__ __forceinline__ void pv_partial(f32x16* o, int vb, bf16x8 pa0, bf16x8 pa1, bf16x8 pa2, bf16x8 pa3, f32x16& p0, f32x16& p1, float& m_reg, float& mn, float& alpha, int j, const MaskCtx& mc, int hi) {
  constexpr float SCALE = (DQK == 128) ? 0.088388347648318440f : 0.125f;
  constexpr float C = SCALE * 1.4426950408889634f;
  apply_mask<MODE>(p0, p1, j, mc, hi);
  pv_one<0>(o[0], vb, pa0, pa1, pa2, pa3);
  float pm0 = p0[0];
#pragma unroll
  for (int r = 1; r < 16; ++r) pm0 = fmaxf(pm0, p0[r]);
  SBAR();
  pv_one<1>(o[1], vb, pa0, pa1, pa2, pa3);
  float pmax = pm0;
#pragma unroll
  for (int r = 0; r < 16; ++r) pmax = fmaxf(pmax, p1[r]);
  { auto rr = __builtin_amdgcn_permlane32_swap(__float_as_uint(pmax), __float_as_uint(pmax), false, false);
    pmax = fmaxf(__uint_as_float(rr[0]), __uint_as_float(rr[1])); }
  if (__builtin_expect(__all(pmax - m_reg <= THR / SCALE), 1)) { mn = m_reg; alpha = 1.f; }
  else { mn = fmaxf(m_reg, pmax); alpha = __builtin_amdgcn_exp2f((m_reg - mn) * C); m_reg = mn; }
  const float mnC = -mn * C;
  SBAR();
  pv_one<2>(o[2], vb, pa0, pa1, pa2, pa3);
#pragma unroll
  for (int r = 0; r < 16; ++r) p0[r] = fmaf(p0[r], C, mnC);
#pragma unroll
  for (int r = 0; r < 16; ++r) p1[r] = fmaf(p1[r], C, mnC);
  SBAR();
  pv_one<3>(o[3], vb, pa0, pa1, pa2, pa3);
#pragma unroll
  for (int r = 0; r < 16; ++r) p0[r] = __builtin_amdgcn_exp2f(p0[r]);
}

template <int DQK, int MODE>
__device__ __forceinline__ void attn_core(const bf16* __restrict__ Qb, const bf16* __restrict__ Kh, const bf16* __restrict__ Vh, const int NT, const int band0,
                                          const MaskCtx& mc, char* lds, f32x16 (&o)[4], float& m_reg, float& l_reg) {
  int tid_ = threadIdx.x; asm volatile("" : "+v"(tid_));
  const int tid = tid_, wid = tid >> 6, lane = tid & 63, r32 = lane & 31, hi = lane >> 5;
  constexpr int NSL = (MODE == 0) ? NSLOT : 2;
  bf16* V_lds = (bf16*)lds; bf16* K_lds = (bf16*)(lds + NSL * SHM_V);
  float* ws = (float*)(lds + OFF_WS) + wid * 64; float* al_l = ws + 32;
  m_reg = -1e30f; l_reg = 0.f;
#pragma unroll
  for (int d = 0; d < 4; ++d) o[d] = f32x16{};
  constexpr bool QREG = (MODE == 0);
  constexpr int SDEPTH = (MODE == 0) ? 2 : 1;
  bf16x8 qr[DQK / 16];
  const bf16* Qw = Qb + (long)(wid * 32 + r32) * LDP + hi * 8;
#pragma unroll
  for (int d0 = 0; d0 < DQK / 16; ++d0) qr[d0] = ld8(Qw + d0 * 16);
  char* Qimg = lds + OFF_Q + wid * 8192 + lane * 16;
  const int sr = tid >> 4, sc = (tid & 15) * 8, vst0 = v_st(sr, sc), vst1 = v_st(32 + sr, sc);
  const int kr64 = tid >> 3, kc64 = (tid & 7) * 8;
  const int vb0 = (int)(uintptr_t)V_lds + v_rd_base(lane);
  struct { bf16x8 vs0, vs1, ks0, ks1; } sr_[SDEPTH];
#define TROW(j) ((MODE == 0 || (j) < 4) ? (j) * 64 : band0 + ((j) - 4) * 64)
  const unsigned offv0 = (unsigned)(sr * LDP + sc), offv1 = (unsigned)((32 + sr) * LDP + sc), offk64 = (unsigned)(kr64 * LDP + kc64);
#define SLOAD(i, j) do { const long k0_ = (long)TROW(j) * LDP; const bf16* vt_ = Vh + k0_; const bf16* kt_ = Kh + k0_; \
    sr_[i].vs0 = ld8(vt_ + offv0); sr_[i].vs1 = ld8(vt_ + offv1); \
    if constexpr (DQK == 128) { sr_[i].ks0 = ld8(kt_ + offv0); sr_[i].ks1 = ld8(kt_ + offv1); } \
    else { sr_[i].ks0 = ld8(kt_ + offk64); } } while (0)
#define SWRITE(so, i) do { *(bf16x8*)((char*)V_lds + (so) + vst0) = sr_[i].vs0; *(bf16x8*)((char*)V_lds + (so) + vst1) = sr_[i].vs1; \
    if constexpr (DQK == 128) { *(bf16x8*)((char*)K_lds + (so) + kswz<128>(sr, sc * 2)) = sr_[i].ks0; *(bf16x8*)((char*)K_lds + (so) + kswz<128>(32 + sr, sc * 2)) = sr_[i].ks1; } \
    else { *(bf16x8*)((char*)K_lds + (so) + kswz<64>(kr64, kc64 * 2)) = sr_[i].ks0; } } while (0)
#define SWAIT() do { if constexpr (SDEPTH == 2) asm volatile("s_waitcnt vmcnt(4)" ::: "memory"); else asm volatile("s_waitcnt vmcnt(0)" ::: "memory"); } while (0)
#define RESC(a) do { if (__any((a) < 1.f)) { if (hi == 0) al_l[r32] = (a); asm volatile("s_waitcnt lgkmcnt(0)" ::: "memory"); \
    _Pragma("unroll") for (int d = 0; d < 4; ++d) _Pragma("unroll") for (int r = 0; r < 16; ++r) o[d][r] *= al_l[crow(r, hi)]; } } while (0)
  f32x16 pA0, pA1, pB0, pB1; float mnA, mnB, alA, alB; bf16x8 pa0, pa1, pa2, pa3;
  constexpr int SE = 0, SO = SDEPTH - 1;
  int s_prev = 0, s_cur = SHM_V, s_next = (NSL == 3) ? 2 * SHM_V : 0;
#define ROT() do { const int t_ = s_prev; s_prev = s_cur; s_cur = s_next; s_next = (NSL == 3) ? t_ : s_prev; } while (0)
  __syncthreads();
  if constexpr (!QREG) {
#pragma unroll
    for (int d0 = 0; d0 < DQK / 16; ++d0) *reinterpret_cast<bf16x8*>(Qimg + d0 * 1024) = qr[d0];
    asm volatile("s_waitcnt lgkmcnt(0)" ::: "memory");
  }
  SLOAD(SE, 0); asm volatile("s_waitcnt vmcnt(0)" ::: "memory"); SWRITE(0, SE); __syncthreads();
  qkt<DQK, QREG>(pA0, pA1, K_lds, qr, Qimg, r32, hi); apply_mask<MODE>(pA0, pA1, 0, mc, hi); partialSM<DQK>(pA0, pA1, m_reg, mnA, alA);
  SLOAD(SO, 1); if constexpr (SDEPTH == 2) { if (2 < NT) SLOAD(SE, 2); }
  SWAIT(); SWRITE(SHM_V, SO); __syncthreads();
  for (int j = 1; j + 1 < NT; j += 2) {
    SBAR(); qkt<DQK, QREG>(pB0, pB1, (bf16*)((char*)K_lds + s_cur), qr, Qimg, r32, hi);
    finishSM(pA0, pA1, alA, l_reg, pa0, pa1, pa2, pa3); SBAR();
    SLOAD(SO, j + SDEPTH); SBAR();
    pv_partial<DQK, MODE>(o, vb0 + s_prev, pa0, pa1, pa2, pa3, pB0, pB1, m_reg, mnB, alB, j, mc, hi);
    if constexpr (NSL == 2) __syncthreads();
    SWAIT(); SWRITE(s_next, SE);
    RESC(alB); __syncthreads(); ROT();
    SBAR(); qkt<DQK, QREG>(pA0, pA1, (bf16*)((char*)K_lds + s_cur), qr, Qimg, r32, hi);
    finishSM(pB0, pB1, alB, l_reg, pa0, pa1, pa2, pa3); SBAR();
    if (SDEPTH == 1 || j + 3 < NT) SLOAD(SE, j + 1 + SDEPTH); SBAR();
    pv_partial<DQK, MODE>(o, vb0 + s_prev, pa0, pa1, pa2, pa3, pA0, pA1, m_reg, mnA, alA, j + 1, mc, hi);
    if constexpr (NSL == 2) __syncthreads();
    SWAIT(); SWRITE(s_next, SO);
    RESC(alA); __syncthreads(); ROT();
  }
  SBAR(); qkt<DQK, QREG>(pB0, pB1, (bf16*)((char*)K_lds + s_cur), qr, Qimg, r32, hi);
  finishSM(pA0, pA1, alA, l_reg, pa0, pa1, pa2, pa3); SBAR();
  pv_partial<DQK, MODE>(o, vb0 + s_prev, pa0, pa1, pa2, pa3, pB0, pB1, m_reg, mnB, alB, NT - 1, mc, hi);
  RESC(alB);
  finishSM(pB0, pB1, alB, l_reg, pa0, pa1, pa2, pa3); SBAR();
  pv_d0(o, vb0 + s_cur, pa0, pa1, pa2, pa3);
  asm volatile("s_waitcnt vmcnt(0)" ::: "memory");
#undef ROT
#undef TROW
#undef SLOAD
#undef SWRITE
#undef SWAIT
#undef RESC
}

__device__ __forceinline__ void row_recips(float l, float* li_l, int r32, int hi, float (&rli)[16]) {
  if (hi == 0) li_l[r32] = l;
  asm volatile("s_waitcnt lgkmcnt(0)" ::: "memory");
#pragma unroll
  for (int r = 0; r < 16; ++r) rli[r] = __builtin_amdgcn_rcpf(li_l[crow(r, hi)]);
  asm volatile("s_waitcnt lgkmcnt(0)" ::: "memory");
}
__device__ __forceinline__ unsigned short f2bf16(float f) { unsigned u = __builtin_bit_cast(unsigned, f); return (unsigned short)((u + 0x7fffu + ((u >> 16) & 1u)) >> 16); }
#undef SBAR
}
#define LAS __attribute__((address_space(3)))
typedef unsigned short bf16_t;
typedef unsigned v4u __attribute__((ext_vector_type(4)));
typedef unsigned v2u __attribute__((ext_vector_type(2)));
typedef float f32x4 __attribute__((ext_vector_type(4)));
constexpr int NWAVES = 8, NTHR = 512;
constexpr int DM = 2048, SEQ = 8192, CTX = 256, MTOT = SEQ + CTX, INW = 4608, DFF = 5632, UPW = 2 * DFF, NMODC = 6 * DM;
constexpr float EPS = 1e-6f;
constexpr size_t MiB = 1u << 20;
constexpr size_t WS_MOD = 0;
constexpr size_t MOD_BYTES = (size_t)2 * 2 * NMODC * 4;
constexpr size_t WS_BAR = 256 * 1024, CTL_ZERO_BYTES = 512 * 1024;
constexpr size_t WS_GTAB = 384 * 1024;
constexpr int MISC_OFF = 145408;
constexpr size_t WS_WIN = 1 * MiB, WS_WOUT = WS_WIN + 36 * MiB, WS_WUP = WS_WOUT + 16 * MiB, WS_WDN = WS_WUP + 88 * MiB;
constexpr size_t WS_H = WS_WDN + 44 * MiB, WS_XR = WS_H + 33 * MiB, WS_A2 = WS_XR + 66 * MiB, WS_U = WS_A2 + 91 * MiB, WS_END = WS_U + 182 * MiB;
constexpr size_t WS_P = WS_U, WS_Y = WS_U + 76 * MiB, WS_O1 = WS_U + 109 * MiB;
static_assert((size_t)(MTOT + 128) * INW * 2 <= 76 * MiB && (size_t)MTOT * DM * 2 <= 33 * MiB && WS_O1 + 256 * 262144 <= WS_END, "overlay map");
static_assert((size_t)MTOT * UPW * 2 <= 182 * MiB && (size_t)MTOT * DFF * 2 <= 91 * MiB && (size_t)MTOT * DM * 4 <= 66 * MiB, "ws map");
constexpr int LDS_BYTES = 147456;

struct Params {
    const float *x, *c, *ctx, *c_ctx, *w_ada, *b_ada, *norm1_g, *w_in, *w_out, *a_qk_g, *a_lambda, *a_subln_g, *b_qk_g, *c_qk_g, *c_sink, *d_qk_g, *d_rpb, *norm2_g, *w_up, *conv_w, *conv_b, *w_down;
    float* out; unsigned char* ws;
};

#define LDS_WAIT() asm volatile("s_waitcnt lgkmcnt(0)" ::: "memory")
__device__ __forceinline__ unsigned f2bf(float f) { unsigned u = __builtin_bit_cast(unsigned, f); return (u + 0x7fffu + ((u >> 16) & 1u)) >> 16; }
__device__ __forceinline__ unsigned pk2(float lo, float hi) { return f2bf(lo) | (f2bf(hi) << 16); }
__device__ __forceinline__ float bf_lo(unsigned w) { return __builtin_bit_cast(float, w << 16); }
__device__ __forceinline__ float bf_hi(unsigned w) { return __builtin_bit_cast(float, w & 0xffff0000u); }
__device__ __forceinline__ float wave_sum(float v) {
#pragma unroll
    for (int o = 1; o < 64; o <<= 1) v += __shfl_xor(v, o);
    return v;
}
__device__ __forceinline__ float silu_f(float v) { return v / (1.f + __expf(-v)); }

__device__ __forceinline__ void transpose_item(const float* __restrict__ W, int K, int N, bf16_t* __restrict__ WT, LAS float* scr, int item, int lane, bool remap_up = false, bool swap_mid = false) {
    const int nblk = N / 64, kb = item / nblk, nb = item % nblk, k0 = 64 * kb, n0 = 64 * nb;
    f32x4 v[16];
#pragma unroll
    for (int i = 0; i < 16; ++i) v[i] = *(const f32x4*)(W + (size_t)(k0 + 4 * i + (lane >> 4)) * N + n0 + (lane & 15) * 4);
#pragma unroll
    for (int i = 0; i < 16; ++i) { LAS float* s = scr + (4 * i + (lane >> 4)) * 65 + (lane & 15) * 4; s[0] = v[i].x; s[1] = v[i].y; s[2] = v[i].z; s[3] = v[i].w; }
    LDS_WAIT();
    const int c = lane & 7;
    const int d0 = !remap_up ? n0 : (n0 < DFF ? 256 * (n0 / 128) + (n0 % 128) : 256 * ((n0 - DFF) / 128) + 128 + ((n0 - DFF) % 128));
#pragma unroll
    for (int j = 0; j < 8; ++j) { const int n = (lane >> 3) + 8 * j; const LAS float* s = scr + (8 * c) * 65 + n;
        v4u o; o.x = pk2(s[0], s[65]); o.y = pk2(s[130], s[195]); o.z = pk2(s[260], s[325]); o.w = pk2(s[390], s[455]);
        const int nd = swap_mid ? ((((n >> 4) == 1) ? 32 : ((n >> 4) == 2) ? 16 : (n & 48)) + (n & 15)) : n;
        *(v4u*)(WT + (size_t)(d0 + nd) * K + k0 + 8 * c) = o; }
    LDS_WAIT();
}

#define PHASE_IDS() int tid_ = threadIdx.x; asm volatile("" : "+v"(tid_)); const int tid = tid_, lane = tid & 63, wave = __builtin_amdgcn_readfirstlane(tid >> 6); \
    const int gw = blockIdx.x * NWAVES + wave, NGW = gridDim.x * NWAVES; (void)lane; (void)gw; (void)NGW
__device__ __forceinline__ void adaln_gemv(const Params& p, int lo, int hi, int first_wg) {
    PHASE_IDS();
    if ((int)blockIdx.x < first_wg) return;
    const int wg = ((int)blockIdx.x - first_wg) * NWAVES + wave, nwg = ((int)gridDim.x - first_wg) * NWAVES;
    float* mod = (float*)(p.ws + WS_MOD);
    for (int it = lo + wg; it < hi; it += nwg) {
        const int i = it / 3072, r = it % 3072, kc = r / 48, cgp = r % 48, col = cgp * 256 + lane * 4;
        const float* W = p.w_ada + (size_t)i * DM * NMODC + (size_t)(kc * 32) * NMODC + col;
        f32x4 a0 = {0.f, 0.f, 0.f, 0.f}, a1 = {0.f, 0.f, 0.f, 0.f};
#pragma unroll 8
        for (int k = 0; k < 32; ++k) { const f32x4 w = *(const f32x4*)(W + (size_t)k * NMODC);
            const float s0 = silu_f(p.c[kc * 32 + k]), s1 = silu_f(p.c_ctx[kc * 32 + k]); a0 += w * s0; a1 += w * s1; }
        if (kc == 0) { const f32x4 b = *(const f32x4*)(p.b_ada + (size_t)i * NMODC + col); a0 += b; a1 += b; }
        float* m0 = mod + (size_t)(i * 2 + 0) * NMODC + col; float* m1 = mod + (size_t)(i * 2 + 1) * NMODC + col;
        atomicAdd(m0 + 0, a0.x); atomicAdd(m0 + 1, a0.y); atomicAdd(m0 + 2, a0.z); atomicAdd(m0 + 3, a0.w);
        atomicAdd(m1 + 0, a1.x); atomicAdd(m1 + 1, a1.y); atomicAdd(m1 + 2, a1.z); atomicAdd(m1 + 3, a1.w);
    }
}
__device__ __forceinline__ void prologue_phase(const Params& p, LAS unsigned char* lds) {
    PHASE_IDS();
    if (blockIdx.x == 0) { float* gt = (float*)(p.ws + WS_GTAB);
        for (int q = tid; q < 896; q += NTHR) gt[q] = q < 128 ? p.a_qk_g[q] : q < 384 ? p.b_qk_g[q - 128] : q < 640 ? p.c_qk_g[q - 384] : p.d_qk_g[q - 640]; }
}

constexpr int I_IN = (DM / 64) * (INW / 64), I_OUT = (DM / 64) * (DM / 64), I_UP = (DM / 64) * (UPW / 64), I_DN = (DFF / 64) * (DM / 64), I_L = I_IN + I_OUT + I_UP + I_DN;
__device__ __forceinline__ void convert_items(const Params& p, LAS unsigned char* lds, int lo, int hi, int first_wg) {
    PHASE_IDS();
    if ((int)blockIdx.x < first_wg) return;
    LAS float* scr = (LAS float*)(lds + wave * 16640);
    bf16_t* Win = (bf16_t*)(p.ws + WS_WIN); bf16_t* Wout = (bf16_t*)(p.ws + WS_WOUT); bf16_t* Wup = (bf16_t*)(p.ws + WS_WUP); bf16_t* Wdn = (bf16_t*)(p.ws + WS_WDN);
    const int wg = ((int)blockIdx.x - first_wg) * NWAVES + wave, nwg = ((int)gridDim.x - first_wg) * NWAVES;
    for (int it = lo + wg; it < hi; it += nwg) {
        const int i = it / I_L; int r = it % I_L;
        if (r < I_IN) { const int n0 = (r % (INW / 64)) * 64;
            const bool sw = (i == 0) ? (n0 >= 3072 && n0 < 4352) : (n0 < 1280);
            transpose_item(p.w_in + (size_t)i * DM * INW, DM, INW, Win + (size_t)i * INW * DM, scr, r, lane, false, sw); continue; } r -= I_IN;
        if (r < I_OUT) { transpose_item(p.w_out + (size_t)i * DM * DM, DM, DM, Wout + (size_t)i * DM * DM, scr, r, lane); continue; } r -= I_OUT;
        if (r < I_UP) { transpose_item(p.w_up + (size_t)i * DM * UPW, DM, UPW, Wup + (size_t)i * UPW * DM, scr, r, lane, true); continue; } r -= I_UP;
        transpose_item(p.w_down + (size_t)i * DFF * DM, DFF, DM, Wdn + (size_t)i * DM * DFF, scr, r, lane);
    }
}

__device__ __forceinline__ void norm_store(const f32x4 (&v)[8], float rstd, int gr, const float* __restrict__ g, const float* md, bf16_t* __restrict__ H, float* copy_ctx, int lane) {
#pragma unroll
    for (int j = 0; j < 8; ++j) { const int col = 4 * lane + 256 * j;
        if (copy_ctx && gr < CTX) *((f32x4*)(copy_ctx + (size_t)gr * DM) + lane + 64 * j) = v[j];
        const f32x4 g4 = *(const f32x4*)(g + col), sh = *(const f32x4*)(md + col), sc = *(const f32x4*)(md + DM + col);
        const f32x4 y = (v[j] * rstd) * g4, o = y * (sc + 1.f) + sh;
        v2u w; w.x = pk2(o.x, o.y); w.y = pk2(o.z, o.w);
        *(v2u*)(H + (size_t)gr * DM + col) = w; }
}
__device__ __forceinline__ void norm_phase(const float* src_ctx, const float* src_lat, const float* __restrict__ g, const float* mod_lat, const float* mod_ctx, int sidx,
                                           bf16_t* __restrict__ H, int row_lo, float* copy_ctx = nullptr) {
    PHASE_IDS();
    for (int gr0 = row_lo + gw; gr0 < MTOT; gr0 += 2 * NGW) {
        const int gr1 = gr0 + NGW; const bool has1 = gr1 < MTOT; const int grb = has1 ? gr1 : gr0;
        const float* xr0 = (gr0 < CTX ? src_ctx : src_lat) + (size_t)gr0 * DM; const float* xr1 = (grb < CTX ? src_ctx : src_lat) + (size_t)grb * DM;
        f32x4 v0[8], v1[8]; float ss0 = 0.f, ss1 = 0.f;
#pragma unroll
        for (int j = 0; j < 8; ++j) { v0[j] = *((const f32x4*)xr0 + lane + 64 * j); v1[j] = *((const f32x4*)xr1 + lane + 64 * j); }
#pragma unroll
        for (int j = 0; j < 8; ++j) { ss0 += (v0[j].x * v0[j].x + v0[j].y * v0[j].y) + (v0[j].z * v0[j].z + v0[j].w * v0[j].w); ss1 += (v1[j].x * v1[j].x + v1[j].y * v1[j].y) + (v1[j].z * v1[j].z + v1[j].w * v1[j].w); }
        const float rstd0 = rsqrtf(wave_sum(ss0) * (1.f / DM) + EPS), rstd1 = rsqrtf(wave_sum(ss1) * (1.f / DM) + EPS);
        norm_store(v0, rstd0, gr0, g, (gr0 < CTX ? mod_ctx : mod_lat) + (size_t)sidx * DM, H, copy_ctx, lane);
        if (has1) norm_store(v1, rstd1, gr1, g, (gr1 < CTX ? mod_ctx : mod_lat) + (size_t)sidx * DM, H, copy_ctx, lane);
    }
}

template <int LAYER>
__device__ __forceinline__ void qkrope_phase(const Params& p, bf16_t* P) {
    PHASE_IDS();
    for (int gr = gw; gr < MTOT + 128; gr += NGW) {
        if (gr >= MTOT) {
            for (int ch = lane; ch < INW / 8; ch += 64) *(v4u*)(P + (size_t)gr * INW + ch * 8) = (v4u){0u, 0u, 0u, 0u};
            continue;
        }
        const bool lat = gr >= CTX; const int tpos = gr - CTX;
#pragma unroll 1
        for (int it = 0; it < 7; ++it) {
            const int cgp = it * 64 + lane; const bool act = cgp < 416; const int ch = act ? cgp : 415;
            int col; bool w64; const float* g; bool rope;
            if (LAYER == 0) {
                col = ch < 256 ? 8 * ch : 3072 + 8 * (ch - 256); w64 = ch < 256; rope = lat;
                g = ch < 128 ? p.a_qk_g : ch < 256 ? p.a_qk_g + 64 : ch < 384 ? p.b_qk_g : p.b_qk_g + 128;
            } else {
                col = ch < 160 ? 8 * ch : 1536 + 8 * (ch - 160); w64 = false; rope = lat && ch < 160;
                g = ch < 128 ? p.c_qk_g : ch < 160 ? p.c_qk_g + 128 : ch < 288 ? p.d_qk_g : p.d_qk_g + 128;
            }
            bf16_t* ptr = P + (size_t)gr * INW + col;
            const v4u raw = *(const v4u*)ptr;
            float xv[8] = {bf_lo(raw.x), bf_hi(raw.x), bf_lo(raw.y), bf_hi(raw.y), bf_lo(raw.z), bf_hi(raw.z), bf_lo(raw.w), bf_hi(raw.w)};
            float ss = 0.f;
#pragma unroll
            for (int e = 0; e < 8; ++e) ss += xv[e] * xv[e];
            ss += __shfl_xor(ss, 1); ss += __shfl_xor(ss, 2); ss += __shfl_xor(ss, 4);
            const float ss8 = __shfl_xor(ss, 8);
            if (!w64) ss += ss8;
            const float rstd = rsqrtf(ss * (w64 ? 1.f / 64.f : 1.f / 128.f) + EPS);
            const int dbase = w64 ? (col & 63) : (col & 127);
            const f32x4 ga = *(const f32x4*)(g + dbase), gb = *(const f32x4*)(g + dbase + 4);
            const float gg[8] = {ga.x, ga.y, ga.z, ga.w, gb.x, gb.y, gb.z, gb.w};
#pragma unroll
            for (int e = 0; e < 8; ++e) xv[e] = xv[e] * rstd * gg[e];
            const int L = w64 ? (ch & 7) : (ch & 15);
            const int sub = w64 ? (L >> 2) : (L >> 3);
            const bool first = w64 ? ((L & 2) == 0) : ((L & 4) == 0);
            const int fi0 = w64 ? 8 * (L & 1) : 8 * (L & 3);
            const float fstep = w64 ? (-13.287712379549449f / 16.f) : (-13.287712379549449f / 32.f);
            const float pos = (float)(sub ? (tpos & 63) : (tpos >> 6));
            float ov[8];
#pragma unroll
            for (int e = 0; e < 8; ++e) {
                const float o2 = __shfl_xor(xv[e], 2), o4 = __shfl_xor(xv[e], 4);
                const float other = w64 ? o2 : o4;
                const float ang = pos * __builtin_amdgcn_exp2f((float)(fi0 + e) * fstep);
                const float cs = __cosf(ang), sn = __sinf(ang);
                const float rot = first ? xv[e] * cs - other * sn : xv[e] * cs + other * sn;
                ov[e] = rope ? rot : xv[e];
            }
            if (act) { v4u w; w.x = pk2(ov[0], ov[1]); w.y = pk2(ov[2], ov[3]); w.z = pk2(ov[4], ov[5]); w.w = pk2(ov[6], ov[7]); *(v4u*)ptr = w; }
        }
    }
}

__device__ __forceinline__ void conv_phase(const bf16_t* __restrict__ U, const float* __restrict__ cw, const float* __restrict__ cb, bf16_t* __restrict__ A2, int run_lo) {
    PHASE_IDS(); const long gtid = (long)blockIdx.x * NTHR + tid, NT_all = (long)gridDim.x * NTHR;
    constexpr int NCH = DFF / 8;
    for (long it = (long)run_lo * NCH + gtid; it < (long)(MTOT / 8) * NCH; it += NT_all) {
        const int run = (int)(it / NCH), ch = (int)(it % NCH), t0 = run * 8, c0 = ch * 8;
        const int lo = t0 < CTX ? 0 : CTX, hi = t0 < CTX ? CTX : MTOT;
        float wa[3][8], wg[3][8], ba[8], bg[8];
#pragma unroll
        for (int j = 0; j < 3; ++j)
#pragma unroll
            for (int e = 0; e < 8; e += 4) { const f32x4 a = *(const f32x4*)(cw + (size_t)j * UPW + c0 + e), g = *(const f32x4*)(cw + (size_t)j * UPW + DFF + c0 + e);
                wa[j][e] = a.x; wa[j][e + 1] = a.y; wa[j][e + 2] = a.z; wa[j][e + 3] = a.w; wg[j][e] = g.x; wg[j][e + 1] = g.y; wg[j][e + 2] = g.z; wg[j][e + 3] = g.w; }
#pragma unroll
        for (int e = 0; e < 8; e += 4) { const f32x4 a = *(const f32x4*)(cb + c0 + e), g = *(const f32x4*)(cb + DFF + c0 + e);
            ba[e] = a.x; ba[e + 1] = a.y; ba[e + 2] = a.z; ba[e + 3] = a.w; bg[e] = g.x; bg[e + 1] = g.y; bg[e + 2] = g.z; bg[e + 3] = g.w; }
        const v4u z = {0u, 0u, 0u, 0u};
        v4u pa = (t0 - 1 >= lo) ? *(const v4u*)(U + (size_t)(t0 - 1) * UPW + c0) : z, pg = (t0 - 1 >= lo) ? *(const v4u*)(U + (size_t)(t0 - 1) * UPW + DFF + c0) : z;
        v4u ca = *(const v4u*)(U + (size_t)t0 * UPW + c0), cg_ = *(const v4u*)(U + (size_t)t0 * UPW + DFF + c0);
#pragma unroll
        for (int r = 0; r < 8; ++r) {
            const int t = t0 + r;
            const v4u na = (t + 1 < hi) ? *(const v4u*)(U + (size_t)(t + 1) * UPW + c0) : z, ng = (t + 1 < hi) ? *(const v4u*)(U + (size_t)(t + 1) * UPW + DFF + c0) : z;
            float oa[8], og[8];
#define CONV2(k, PW, CW_, NW_, OUT, WT, BS) OUT[2 * k] = BS[2 * k] + bf_lo(PW) * WT[0][2 * k] + bf_lo(CW_) * WT[1][2 * k] + bf_lo(NW_) * WT[2][2 * k]; \
                                              OUT[2 * k + 1] = BS[2 * k + 1] + bf_hi(PW) * WT[0][2 * k + 1] + bf_hi(CW_) * WT[1][2 * k + 1] + bf_hi(NW_) * WT[2][2 * k + 1];
            CONV2(0, pa.x, ca.x, na.x, oa, wa, ba) CONV2(1, pa.y, ca.y, na.y, oa, wa, ba) CONV2(2, pa.z, ca.z, na.z, oa, wa, ba) CONV2(3, pa.w, ca.w, na.w, oa, wa, ba)
            CONV2(0, pg.x, cg_.x, ng.x, og, wg, bg) CONV2(1, pg.y, cg_.y, ng.y, og, wg, bg) CONV2(2, pg.z, cg_.z, ng.z, og, wg, bg) CONV2(3, pg.w, cg_.w, ng.w, og, wg, bg)
#undef CONV2
            float y[8];
#pragma unroll
            for (int e = 0; e < 8; ++e) y[e] = silu_f(og[e]) * oa[e];
            v4u w; w.x = pk2(y[0], y[1]); w.y = pk2(y[2], y[3]); w.z = pk2(y[4], y[5]); w.w = pk2(y[6], y[7]);
            *(v4u*)(A2 + (size_t)t * DFF + c0) = w;
            pa = ca; pg = cg_; ca = na; cg_ = ng;
        }
    }
}

__device__ __forceinline__ void conv_fix_phase(const bf16_t* __restrict__ U, const float* __restrict__ cw, const float* __restrict__ cb, bf16_t* __restrict__ A2, int tile_lo) {
    PHASE_IDS(); const long gtid = (long)blockIdx.x * NTHR + tid, NT_all = (long)gridDim.x * NTHR;
    constexpr int NCH = DFF / 8;
    for (long it = (long)tile_lo * 8 * NCH + gtid; it < (long)(MTOT / 256) * 8 * NCH; it += NT_all) {
        const int rk = (int)(it / NCH), ch = (int)(it % NCH), c0 = ch * 8, tile = rk >> 3, k = rk & 7;
        const int t = tile * 256 + ((k + 1) >> 1) * 64 - (k & 1);
        const int lo = t < CTX ? 0 : CTX, hi = t < CTX ? CTX : MTOT;
        const v4u z = {0u, 0u, 0u, 0u};
        const v4u pa = (t - 1 >= lo) ? *(const v4u*)(U + (size_t)(t - 1) * UPW + c0) : z, pg = (t - 1 >= lo) ? *(const v4u*)(U + (size_t)(t - 1) * UPW + DFF + c0) : z;
        const v4u ca = *(const v4u*)(U + (size_t)t * UPW + c0), cg_ = *(const v4u*)(U + (size_t)t * UPW + DFF + c0);
        const v4u na = (t + 1 < hi) ? *(const v4u*)(U + (size_t)(t + 1) * UPW + c0) : z, ng = (t + 1 < hi) ? *(const v4u*)(U + (size_t)(t + 1) * UPW + DFF + c0) : z;
        const unsigned pav[4] = {pa.x, pa.y, pa.z, pa.w}, pgv[4] = {pg.x, pg.y, pg.z, pg.w}, cav[4] = {ca.x, ca.y, ca.z, ca.w}, cgv[4] = {cg_.x, cg_.y, cg_.z, cg_.w}, nav[4] = {na.x, na.y, na.z, na.w}, ngv[4] = {ng.x, ng.y, ng.z, ng.w};
        unsigned ow[4];
#pragma unroll
        for (int q = 0; q < 4; ++q) {
            float y[2];
#pragma unroll
            for (int e = 0; e < 2; ++e) { const int c = c0 + 2 * q + e;
                const float xa0 = e ? bf_hi(pav[q]) : bf_lo(pav[q]), xa1 = e ? bf_hi(cav[q]) : bf_lo(cav[q]), xa2 = e ? bf_hi(nav[q]) : bf_lo(nav[q]);
                const float xg0 = e ? bf_hi(pgv[q]) : bf_lo(pgv[q]), xg1 = e ? bf_hi(cgv[q]) : bf_lo(cgv[q]), xg2 = e ? bf_hi(ngv[q]) : bf_lo(ngv[q]);
                const float oa = cb[c] + xa0 * cw[c] + xa1 * cw[UPW + c] + xa2 * cw[2 * UPW + c];
                const float og = cb[DFF + c] + xg0 * cw[DFF + c] + xg1 * cw[UPW + DFF + c] + xg2 * cw[2 * UPW + DFF + c];
                y[e] = silu_f(og) * oa; }
            ow[q] = pk2(y[0], y[1]);
        }
        *(v4u*)(A2 + (size_t)t * DFF + c0) = (v4u){ow[0], ow[1], ow[2], ow[3]};
    }
}

__device__ __forceinline__ void zero_pad_rows(bf16_t* P) {
    PHASE_IDS();
    unsigned zz = 0u; asm volatile("" : "+v"(zz));
    for (int q = (int)blockIdx.x * NTHR + tid; q < 128 * INW / 8; q += (int)gridDim.x * NTHR) *(v4u*)(P + (size_t)MTOT * INW + (size_t)q * 8) = (v4u){zz, zz, zz, zz};
}

__device__ __forceinline__ void attn_store(att::f32x16 (&o)[4], float l, char* lds, bf16_t* Yb  ) {
    int tid_ = threadIdx.x; asm volatile("" : "+v"(tid_));
    const int tid = tid_, wid = tid >> 6, lane = tid & 63, r32 = lane & 31, hi = lane >> 5;
    float* li_l = (float*)(lds + att::OFF_WS) + wid * 64;
    float rli[16]; att::row_recips(l, li_l, r32, hi, rli);
#pragma unroll
    for (int r = 0; r < 16; ++r) { const int orow = wid * 32 + att::crow(r, hi);
#pragma unroll
        for (int d0 = 0; d0 < 4; ++d0) Yb[(size_t)orow * att::LDY + d0 * 32 + r32] = (bf16_t)f2bf(o[d0][r] * rli[r]); }
}

__device__ __forceinline__ void attn_store_f32(att::f32x16 (&o)[4], float l, char* lds, float* dst) {
    int tid_ = threadIdx.x; asm volatile("" : "+v"(tid_));
    const int tid = tid_, wid = tid >> 6, lane = tid & 63, r32 = lane & 31, hi = lane >> 5;
    float* li_l = (float*)(lds + att::OFF_WS) + wid * 64;
    float rli[16]; att::row_recips(l, li_l, r32, hi, rli);
#pragma unroll
    for (int r = 0; r < 16; ++r) { const int orow = wid * 32 + att::crow(r, hi);
#pragma unroll
        for (int d0 = 0; d0 < 4; ++d0) dst[orow * 128 + d0 * 32 + r32] = o[d0][r] * rli[r]; }
}

__device__ __forceinline__ void attn_layer0(const Params& p, char* lds, int vcu, int G) {
    const att::bf16* P = (const att::bf16*)(p.ws + WS_P); bf16_t* Y = (bf16_t*)(p.ws + WS_Y);
    int tid_ = threadIdx.x; asm volatile("" : "+v"(tid_));
    const int tid = tid_, wid = tid >> 6, lane = tid & 63;
    const att::MaskCtx mc{0, 0, 0, nullptr};
    float* o12 = (float*)(p.ws + WS_O1) + (size_t)blockIdx.x * 65536;
#pragma unroll 1
    for (int u = vcu; u < 264; u += G) {
        const bool lat = u < 256; const int h = lat ? u >> 5 : u - 256, row0 = lat ? CTX + (u & 31) * 256 : 0, NT = lat ? 132 : 4;
#pragma unroll 1
        for (int m = 0; m < 2; ++m) {
            att::f32x16 o[4]; float m_reg, l_reg;
            att::attn_core<64, 0>(P + (size_t)row0 * INW + h * 128 + m * 64, P + 1024 + h * 128 + m * 64, P + 2048 + h * 128, NT, 0, mc, lds, o, m_reg, l_reg);
            attn_store_f32(o, l_reg, lds, o12 + m * 32768);
        }
        asm volatile("s_waitcnt vmcnt(0)" ::: "memory");
        float s01 = 0.f, s23 = 0.f;
        for (int e = 0; e < 64; ++e) { s01 += p.a_lambda[e] * p.a_lambda[64 + e]; s23 += p.a_lambda[128 + e] * p.a_lambda[192 + e]; }
        const float lam = __expf(s01) - __expf(s23) + 0.2f;
        const float g0 = p.a_subln_g[2 * lane], g1 = p.a_subln_g[2 * lane + 1];
#pragma unroll 4
        for (int rr = 0; rr < 32; ++rr) {
            const int row = wid * 32 + rr;
            const float2 a = *(const float2*)(o12 + row * 128 + 2 * lane), b = *(const float2*)(o12 + 32768 + row * 128 + 2 * lane);
            const float d0 = a.x - lam * b.x, d1 = a.y - lam * b.y;
            const float sc = rsqrtf(wave_sum(d0 * d0 + d1 * d1) * (1.f / 128.f) + EPS) * 0.8f;
            *(unsigned*)(Y + (size_t)(row0 + row) * DM + h * 128 + 2 * lane) = pk2(d0 * sc * g0, d1 * sc * g1);
        }
    }
#pragma unroll 1
    for (int u = vcu; u < 264; u += G) {
        const bool lat = u < 256; const int h = lat ? u >> 5 : u - 256, row0 = lat ? CTX + (u & 31) * 256 : 0, NT = lat ? 132 : 4;
        att::f32x16 o[4]; float m_reg, l_reg;
        att::attn_core<128, 0>(P + (size_t)row0 * INW + 3072 + h * 128, P + 4096 + (h >> 2) * 128, P + 4352 + (h >> 2) * 128, NT, 0, mc, lds, o, m_reg, l_reg);
        attn_store(o, l_reg, lds, Y + (size_t)row0 * DM + 1024 + h * 128);
    }
}

__device__ __forceinline__ void attn_layer1(const Params& p, char* lds, int vcu, int G) {
    const att::bf16* P = (const att::bf16*)(p.ws + WS_P); bf16_t* Y = (bf16_t*)(p.ws + WS_Y);
    int tid_ = threadIdx.x; asm volatile("" : "+v"(tid_));
    const int tid = tid_, wid = tid >> 6, lane = tid & 63, r32 = lane & 31;
#pragma unroll 1
    for (int u = vcu; u < 256; u += G) {
        const int h = u >> 5, qb = u & 31, q0 = qb * 256, row0 = CTX + q0;
        const att::MaskCtx mc{q0 + wid * 32 + r32, q0 - 128, 0, nullptr};
        att::f32x16 o[4]; float m_reg, l_reg;
        att::attn_core<128, 1>(P + (size_t)row0 * INW + h * 128, P + 1024 + (h >> 2) * 128, P + 1280 + (h >> 2) * 128, 12, CTX + q0 - 128, mc, lds, o, m_reg, l_reg);
        constexpr float C = 0.088388347648318440f * 1.4426950408889634f;
        const float l = l_reg + __builtin_amdgcn_exp2f(p.c_sink[h] * 1.4426950408889634f - m_reg * C);
        attn_store(o, l, lds, Y + (size_t)row0 * DM + h * 128);
    }
    float* tab = (float*)(lds + att::OFF_TAB);
#pragma unroll 1
    for (int u = vcu; u < 256; u += G) {
        const int h = u >> 5, qb = u & 31, q0 = qb * 256, row0 = CTX + q0, r0 = qb * 4;
        const int base = min(max(r0 - 4, 0), 116);
        __syncthreads();
        if (tid < 465) tab[tid] = p.d_rpb[h * 465 + tid] * 11.313708498984761f;
        const att::MaskCtx mc{r0 + (wid >> 1), (wid & 1) * 32 + r32, base, tab};
        att::f32x16 o[4]; float m_reg, l_reg;
        att::attn_core<128, 2>(P + (size_t)row0 * INW + 1536 + h * 128, P + 2560 + h * 128, P + 3584 + h * 128, 16, CTX + base * 64, mc, lds, o, m_reg, l_reg);
        attn_store(o, l_reg, lds, Y + (size_t)row0 * DM + 1024 + h * 128);
    }
}

#define GAS __attribute__((address_space(1)))
typedef GAS unsigned gu32;
typedef GAS unsigned long long gu64;
#define RLX_AGENT __ATOMIC_RELAXED, __HIP_MEMORY_SCOPE_AGENT
#define XB_TMO      128
#define XB_XCNT(j)  (256  + 64 * (j))
#define XB_XSUB(j)  (1280 + 64 * (j))
#define XB_XGEN(j)  (2304 + 64 * (j))
#define XB_TOP      3328
#define XB_TOPGEN   3392
#define XCD_BAR_WORDS 3456
#define XB_SPIN_CAP (1u << 18)

__device__ __forceinline__ unsigned xb_ld(unsigned* p)              { return __hip_atomic_load(p, __ATOMIC_RELAXED, __HIP_MEMORY_SCOPE_AGENT); }
__device__ __forceinline__ unsigned xb_add(unsigned* p, unsigned v) { return __hip_atomic_fetch_add(p, v, __ATOMIC_RELAXED, __HIP_MEMORY_SCOPE_AGENT); }
__device__ __forceinline__ unsigned xb_xcc_id() { return (unsigned)__builtin_amdgcn_s_getreg((3 << 11) | 20) & 0xFu; }
#define XB_SPIN(cond, bar) do { unsigned _sp = 0; while (cond) { __builtin_amdgcn_s_sleep(1); \
    if ((++_sp & 255u) == 0u) { if (xb_ld(&(bar)[XB_TMO])) break; if (_sp > XB_SPIN_CAP) { atomicAdd(&(bar)[XB_TMO], 1u); break; } } } } while (0)

struct XcdBarrier {
    unsigned* bar; unsigned x;
    volatile LAS unsigned* st;
};

__device__ __forceinline__ XcdBarrier xcd_barrier_post(unsigned* bar, volatile LAS unsigned* st) {
    XcdBarrier b; b.bar = bar; b.x = xb_xcc_id(); b.st = st;
    if (threadIdx.x == 0) (void)xb_add(&bar[XB_XCNT(b.x)], 1u);
    return b;
}
__device__ __forceinline__ void xcd_barrier_complete(unsigned* bar, unsigned x, unsigned& nloc, unsigned& nx) {
    const unsigned G = gridDim.x * gridDim.y * gridDim.z;
    unsigned sum, cnt, mine, sp = 0u;
    for (;;) {
        sum = 0u; cnt = 0u; mine = 0u;
#pragma unroll
        for (unsigned j = 0; j < 16; ++j) { const unsigned c = xb_ld(&bar[XB_XCNT(j)]); sum += c; cnt += (c > 0u) ? 1u : 0u; mine = (j == x) ? c : mine; }
        if (sum == G) break;
        __builtin_amdgcn_s_sleep(1);
        if ((++sp & 255u) == 0u) { if (xb_ld(&bar[XB_TMO])) break; if (sp > XB_SPIN_CAP) { atomicAdd(&bar[XB_TMO], 1u); break; } }
    }
    nloc = mine > 0u ? mine : 1u; nx = cnt > 0u ? cnt : 1u;
}

__device__ __forceinline__ void xcd_barrier(const XcdBarrier& b) {
    asm volatile("s_waitcnt vmcnt(0)" ::: "memory");
    __syncthreads();
    if (threadIdx.x == 0) {
        unsigned* bar = b.bar; asm volatile("" : "+s"(bar));
        unsigned bx_ = b.x; asm volatile("" : "+s"(bx_));
        __builtin_amdgcn_s_waitcnt(0);
        unsigned nloc = b.st[0], nx = b.st[1];
        if (nloc == 0u) { xcd_barrier_complete(bar, bx_, nloc, nx); b.st[0] = nloc; b.st[1] = nx; }
        const unsigned old = xb_add(&bar[XB_XSUB(bx_)], 1u);
        const unsigned gen = old / nloc;
        if (old + 1u == (gen + 1u) * nloc) {
            __builtin_amdgcn_fence(__ATOMIC_RELEASE, "agent");
            asm volatile("s_waitcnt vmcnt(0)" ::: "memory");
            const unsigned og = xb_add(&bar[XB_TOP], 1u);
            const unsigned tg = og / nx;
            if (og + 1u == (tg + 1u) * nx) xb_add(&bar[XB_TOPGEN], 1u);
            else XB_SPIN(xb_ld(&bar[XB_TOPGEN]) == tg, bar);
            __builtin_amdgcn_fence(__ATOMIC_ACQUIRE, "agent");
            xb_add(&bar[XB_XGEN(bx_)], 1u);
            asm volatile("s_waitcnt vmcnt(0)" ::: "memory");
        } else {
            XB_SPIN(xb_ld(&bar[XB_XGEN(bx_)]) == gen, bar);
            __builtin_amdgcn_fence(__ATOMIC_ACQUIRE, "agent");
            asm volatile("s_waitcnt vmcnt(0)" ::: "memory");
        }
    }
    __syncthreads();
}

__global__ void __launch_bounds__(NTHR, 2) mega_fwd(Params p) {
    extern __shared__ __attribute__((aligned(16))) unsigned char lds_raw[];
    cg::grid_group grid = cg::this_grid();
    LAS unsigned char* lds = (LAS unsigned char*)lds_raw;
    const int G = gridDim.x, bx = blockIdx.x, vcu = (G % 8 == 0) ? (bx % 8) * (G / 8) + bx / 8 : bx;
    unsigned char* ws = p.ws;
    float* mod = (float*)(ws + WS_MOD);
    bf16_t* H = (bf16_t*)(ws + WS_H); float* XR = (float*)(ws + WS_XR); bf16_t* A2 = (bf16_t*)(ws + WS_A2); bf16_t* U = (bf16_t*)(ws + WS_U);
    bf16_t* P = (bf16_t*)(ws + WS_P); bf16_t* Y = (bf16_t*)(ws + WS_Y);

    volatile LAS unsigned* misc = (volatile LAS unsigned*)(lds + MISC_OFF);
    if (threadIdx.x < 2) misc[threadIdx.x] = 0u;
    __syncthreads();
    const XcdBarrier bar = xcd_barrier_post((unsigned*)(ws + WS_BAR), misc);
#define GRID_SYNC() xcd_barrier(bar)
    prologue_phase(p, lds);
    adaln_gemv(p, 0, 3072, 0);
    convert_items(p, lds, 0, I_IN, 0);
    if (p.ws == nullptr) grid.sync();
    GRID_SYNC();
#pragma unroll 1
    for (int i = 0; i < 2; ++i) {
        const float* mod_lat = mod + (size_t)(i * 2 + 0) * NMODC; const float* mod_ctx = mod + (size_t)(i * 2 + 1) * NMODC;
        const bf16_t* Win = (const bf16_t*)(ws + WS_WIN) + (size_t)i * INW * DM; const bf16_t* Wout = (const bf16_t*)(ws + WS_WOUT) + (size_t)i * DM * DM;
        const bf16_t* Wup = (const bf16_t*)(ws + WS_WUP) + (size_t)i * UPW * DM; const bf16_t* Wdn = (const bf16_t*)(ws + WS_WDN) + (size_t)i * DM * DFF;
        if (i == 0) norm_phase(p.ctx, p.x - (size_t)CTX * DM, p.norm1_g, mod_lat, mod_ctx, 0, H, 0, XR);
        else      { norm_phase(XR, XR, p.norm1_g + DM, mod_lat, mod_ctx, 0, H, 0); zero_pad_rows(P); }
        GRID_SYNC();
        { pg8::Gemm g{H, Win, MTOT, INW, DM, DM}; pg8::StaticOrder S; S.init(MTOT, INW, G, bx);
          PG8_LAS float* part = (PG8_LAS float*)(lds + 131072);
          if (i == 0) { const pg8::EpiQKV<0> E{P, (const float*)(ws + WS_GTAB), part}; pg8::gemm_phase<pg8::EpiQKV<0>, pg8::StaticOrder, true, true>(lds, g, S, E); }
          else        { const pg8::EpiQKV<1> E{P, (const float*)(ws + WS_GTAB) + 384, part}; pg8::gemm_phase<pg8::EpiQKV<1>, pg8::StaticOrder, true, true>(lds, g, S, E); } }
        if (i == 0) convert_items(p, lds, I_IN, I_IN + I_OUT + I_UP, ((MTOT / 256) * (INW / 256)) % G);
        else        convert_items(p, lds, I_L + I_IN, 2 * I_L, ((MTOT / 256) * (INW / 256)) % G);
        GRID_SYNC();
        if (i == 0) attn_layer0(p, (char*)lds_raw, vcu, G); else attn_layer1(p, (char*)lds_raw, vcu, G);
        GRID_SYNC();
        { const pg8::Gemm g{Y + (size_t)CTX * DM, Wout, SEQ, DM, DM, DM};
          pg8::StaticOrder S; S.init(SEQ, DM, G, bx);
          const pg8::EpiGateRes E{XR, (i == 0) ? p.x - (size_t)CTX * DM : XR, XR, mod_ctx + 2 * DM, mod_lat + 2 * DM, CTX};
          pg8::gemm_phase<pg8::EpiGateRes, pg8::StaticOrder, true, true>(lds, g, S, E); }
        if (i == 0) { const pg8::Gemm g{Y, Wout, CTX, DM, 256, DM};
          const pg8::SplitKOrder S{DM / 256, (DM / 256) * (DM / 256), 256, G, bx};
          const pg8::EpiGateAtomic E{XR, mod_ctx + 2 * DM};
          pg8::gemm_phase<pg8::EpiGateAtomic, pg8::SplitKOrder, false, true>(lds, g, S, E); }
        GRID_SYNC();
        norm_phase(XR, XR, p.norm2_g + (size_t)i * DM, mod_lat, mod_ctx, 3, H, i == 0 ? 0 : CTX);
        GRID_SYNC();
        { const pg8::Gemm g = (i == 0) ? pg8::Gemm{H, Wup, MTOT, UPW, DM, DM} : pg8::Gemm{H + (size_t)CTX * DM, Wup, SEQ, UPW, DM, DM};
          pg8::StaticOrder S; S.init(g.M, UPW, G, bx);
          const pg8::EpiConvGate E{A2, U, p.conv_w + (size_t)i * 3 * UPW, p.conv_b + (size_t)i * UPW, (i == 0) ? 0 : CTX};
          pg8::gemm_phase<pg8::EpiConvGate, pg8::StaticOrder, true, true>(lds, g, S, E); }
        if (i == 0) convert_items(p, lds, I_IN + I_OUT + I_UP, I_L + I_IN, ((MTOT / 256) * (UPW / 256)) % G);
        GRID_SYNC();
        conv_fix_phase(U, p.conv_w + (size_t)i * 3 * UPW, p.conv_b + (size_t)i * UPW, A2, i == 0 ? 0 : 1);
        GRID_SYNC();
        { const pg8::Gemm g{A2 + (size_t)CTX * DFF, Wdn, SEQ, DM, DFF, DFF};
          pg8::StaticOrder S; S.init(SEQ, DM, G, bx);
          const pg8::EpiGateRes E{XR, XR, (i == 0) ? XR : p.out - (size_t)CTX * DM, mod_ctx + 5 * DM, mod_lat + 5 * DM, CTX};
          pg8::gemm_phase<pg8::EpiGateRes, pg8::StaticOrder, true, true>(lds, g, S, E); }
        if (i == 0) { const pg8::Gemm g{A2, Wdn, CTX, DM, 512, DFF};
          const pg8::SplitKOrder S{DM / 256, (DM / 256) * (DFF / 512), 512, G, bx};
          const pg8::EpiGateAtomic E{XR, mod_ctx + 5 * DM};
          pg8::gemm_phase<pg8::EpiGateAtomic, pg8::SplitKOrder, false, true>(lds, g, S, E); }
        if (i == 0) { adaln_gemv(p, 3072, 6144, ((DM / 256) * (DFF / 512)) % G); GRID_SYNC(); }
    }
}

extern "C" void kernel_launch(void* const* d_in, const int* in_sizes, int n_in, void* d_out, int out_size, void* d_ws, size_t ws_size, hipStream_t stream) {
    static int grid = 0;
    if (grid == 0) {
        if (n_in != 22 || in_sizes[0] != SEQ * DM || out_size != SEQ * DM || ws_size < WS_END) {
            fprintf(stderr, "kernel_launch: unexpected shapes (n_in %d, in0 %d, out %d, ws %zu < %zu); nothing launched\n", n_in, n_in > 0 ? in_sizes[0] : -1, out_size, ws_size, (size_t)WS_END);
            grid = -1; return; }
        int dev = 0, cus = 0, per_cu = 0;
        (void)hipGetDevice(&dev); (void)hipDeviceGetAttribute(&cus, hipDeviceAttributeMultiprocessorCount, dev);
        if (hipFuncSetAttribute((const void*)mega_fwd, hipFuncAttributeMaxDynamicSharedMemorySize, LDS_BYTES) != hipSuccess) { fprintf(stderr, "kernel_launch: hipFuncSetAttribute failed\n"); grid = -1; return; }
        if (hipOccupancyMaxActiveBlocksPerMultiprocessor(&per_cu, (const void*)mega_fwd, NTHR, LDS_BYTES) != hipSuccess || per_cu < 1) { (void)hipGetLastError(); per_cu = 1; }
        grid = cus * (per_cu > 1 ? 1 : per_cu);
        if (grid <= 0) grid = 256;
    }
    if (grid < 0) return;
    (void)hipMemsetAsync((char*)d_ws + WS_MOD, 0, CTL_ZERO_BYTES, stream);
    Params p{};
    const float** pp = (const float**)&p;
    for (int i = 0; i < 22; ++i) pp[i] = (const float*)d_in[i];
    p.out = (float*)d_out; p.ws = (unsigned char*)d_ws;
    void* args[] = {&p};
    hipError_t e = hipLaunchCooperativeKernel((const void*)mega_fwd, dim3(grid), dim3(NTHR), args, LDS_BYTES, stream);
    if (e != hipSuccess) fprintf(stderr, "cooperative launch failed: %s (grid %d)\n", hipGetErrorString(e), grid);
}
```

```cpp
#include <hip/hip_runtime.h>
#include <hip/hip_cooperative_groups.h>
#include <hip/hip_bf16.h>
#include <cstdio>
#include <cstdint>
#include <cmath>
namespace cg = cooperative_groups;
namespace pg8 {
#define PG8_LAS __attribute__((address_space(3)))
typedef unsigned short bf16_t;
typedef short bf16x8 __attribute__((ext_vector_type(8)));
typedef float f32x4 __attribute__((ext_vector_type(4)));
typedef unsigned u32x4 __attribute__((ext_vector_type(4)));
constexpr int BM = 256, BK = 64, HALF = 128, HTB = HALF * BK * 2  , STAGE_BYTES = 8 * HTB, NXCD = 8, WGM = 8;

__host__ __device__ __forceinline__ int lds_byte(int r, int c) { const int st = (r >> 4) * 2 + (c >> 5), rr = r & 15, cc = c & 31, ob = rr * 64 + cc * 2; return st * 1024 + (ob ^ (((ob >> 9) & 1) << 5)); }
__host__ __device__ __forceinline__ void stage_rc(int b, int& R, int& C) { const int st = b / 1024, sb = b % 1024, swz = sb ^ (((sb >> 9) & 1) << 5); R = (st >> 1) * 16 + swz / 64; C = (st & 1) * 32 + (swz % 64) / 2; }
__host__ __device__ __forceinline__ int perm32(int rho) { const int n = rho >> 4, i = rho & 15; return 8 * (i >> 2) + 4 * n + (i & 3); }

struct Unit { int pm, pn, k0; };
struct Gemm { const bf16_t* A; const bf16_t* Bt; int M, N, K, ld; };

struct StaticOrder {
    int nM, nN, nwg, G, c;
    __host__ __device__ void init(int M, int N, int G_, int c_) { nM = M / BM; nN = N / BM; nwg = nM * nN; G = G_; c = c_; }
    __host__ __device__ bool next(int i, Unit& u) const {
        const long L = (long)i * G + c; if (L >= nwg) return false;
        int wgid = (int)L; { const int q = nwg / NXCD, r = nwg % NXCD, xcd = wgid % NXCD, off = wgid / NXCD; wgid = (xcd < r ? xcd * (q + 1) : r * (q + 1) + (xcd - r) * q) + off; }
        const int nig = WGM * nN, gid = wgid / nig, fm = gid * WGM, gsz = (nM - fm) < WGM ? (nM - fm) : WGM;
        u.pm = fm + ((wgid % nig) % gsz); u.pn = (wgid % nig) / gsz; u.k0 = 0; return true;
    }
    __device__ __forceinline__ void a_ready(const Unit&) const {}
    __device__ __forceinline__ void done(const Unit&) const {}
};

__device__ __forceinline__ unsigned cvt_pk_bf16(float lo, float hi) { unsigned r; asm volatile("v_cvt_pk_bf16_f32 %0, %1, %2" : "=v"(r) : "v"(lo), "v"(hi)); return r; }
typedef float f32x2 __attribute__((ext_vector_type(2)));
__device__ __forceinline__ f32x2 gelu_pk(f32x2 v) {
    const f32x2 av = __builtin_elementwise_abs(v), d = av * 0.2316418882f + 1.0f;
    f32x2 t; t.x = __builtin_amdgcn_rcpf(d.x); t.y = __builtin_amdgcn_rcpf(d.y);
    f32x2 q = t * 0.5307027145f + (-0.7265760135f); q = q * t + 0.7107068705f; q = q * t + (-0.142248368f); q = q * t + 0.127414796f; q = q * t;
    const f32x2 s = (v * v) * (-0.72134752044f);
    f32x2 e; e.x = __builtin_amdgcn_exp2f(s.x); e.y = __builtin_amdgcn_exp2f(s.y);
    const f32x2 m = v * (q * e), r = v - m;
    f32x2 o; o.x = v.x < 0.f ? m.x : r.x; o.y = v.y < 0.f ? m.y : r.y; return o;
}

template <int ACT  > struct EpiBf16 {
    static constexpr bool PERM = true, AFTER_DRAIN = false; static_assert(ACT == 0 || ACT == 1, "EpiBf16: ACT is 0 (none) or 1 (gelu_pk)");
    bf16_t* O; int ldc; const float* bias; int split_cols; size_t split_stride; float scale0;
    __device__ __forceinline__ void operator()(const f32x4 (&acc)[2][2][4][2], const Unit& u, int wr, int wc, int fr, int fq) const {
        const int row0 = u.pm * BM + wr * 64 + fr; int colt = u.pn * BM; bf16_t* base = O;
        float sc = 1.f; if (split_cols) { const int t = colt / split_cols; base += (size_t)t * split_stride; colt -= t * split_cols; if (t == 0) sc = scale0; }
        const int col0 = colt + wc * 32 + 8 * fq, bcol0 = u.pn * BM + wc * 32 + 8 * fq;
        f32x4 bv[2][2];
#pragma unroll
        for (int bj = 0; bj < 2; ++bj)
#pragma unroll
            for (int n = 0; n < 2; ++n) bv[bj][n] = bias ? *(const f32x4*)(bias + bcol0 + bj * HALF + 4 * n) : (f32x4){0.f, 0.f, 0.f, 0.f};
#pragma unroll
        for (int ai = 0; ai < 2; ++ai)
#pragma unroll
            for (int m = 0; m < 4; ++m) { bf16_t* rowp = base + (size_t)(row0 + ai * HALF + m * 16) * ldc + col0;
#pragma unroll
                for (int bj = 0; bj < 2; ++bj) { f32x4 v0 = acc[ai][bj][m][0] + bv[bj][0], v1 = acc[ai][bj][m][1] + bv[bj][1];
                    if (ACT == 1) { f32x2 a = gelu_pk((f32x2){v0[0], v0[1]}), b = gelu_pk((f32x2){v0[2], v0[3]}), c = gelu_pk((f32x2){v1[0], v1[1]}), d = gelu_pk((f32x2){v1[2], v1[3]});
                        v0 = (f32x4){a.x, a.y, b.x, b.y}; v1 = (f32x4){c.x, c.y, d.x, d.y}; }
                    v0 = v0 * sc; v1 = v1 * sc; u32x4 w; w.x = cvt_pk_bf16(v0[0], v0[1]); w.y = cvt_pk_bf16(v0[2], v0[3]); w.z = cvt_pk_bf16(v1[0], v1[1]); w.w = cvt_pk_bf16(v1[2], v1[3]);
                    *(u32x4*)(rowp + bj * HALF) = w; } }
    }
};
typedef unsigned u32x2_t __attribute__((ext_vector_type(2)));
struct EpiGateRes {
    static constexpr bool PERM = false, AFTER_DRAIN = false;
    const float* base_ctx; const float* base_lat; float* out; const float* gate_ctx; const float* gate_lat; int row_off;
    __device__ __forceinline__ void operator()(const f32x4 (&acc)[2][2][4][2], const Unit& u, int wr, int wc, int fr, int fq) const {
        const int grow0 = row_off + u.pm * BM; const bool isctx = grow0 < 256;
        const float* base = isctx ? base_ctx : base_lat; const float* gate = isctx ? gate_ctx : gate_lat;
        const int col0 = u.pn * BM + wc * 32 + 4 * fq;
        f32x4 gv[2][2];
#pragma unroll
        for (int bj = 0; bj < 2; ++bj)
#pragma unroll
            for (int n = 0; n < 2; ++n) gv[bj][n] = *(const f32x4*)(gate + col0 + bj * HALF + n * 16);
#pragma unroll
        for (int ai = 0; ai < 2; ++ai)
#pragma unroll
            for (int m = 0; m < 4; ++m) { const size_t off = (size_t)(grow0 + ai * HALF + wr * 64 + m * 16 + fr) * 2048 + col0;
#pragma unroll
                for (int bj = 0; bj < 2; ++bj)
#pragma unroll
                    for (int n = 0; n < 2; ++n) { const f32x4 b = *(const f32x4*)(base + off + bj * HALF + n * 16);
                        *(f32x4*)(out + off + bj * HALF + n * 16) = b + gv[bj][n] * acc[ai][bj][m][n]; }
                if (m & 1) asm volatile("" ::: "memory"); }
    }
};
struct SplitKOrder {
    int nN, nsub, ksub, G, c;
    __device__ bool next(int i, Unit& u) const { const int L = i * G + c; if (L >= nsub) return false; u.pm = 0; u.pn = L % nN; u.k0 = (L / nN) * ksub; return true; }
    __device__ __forceinline__ void a_ready(const Unit&) const {}
    __device__ __forceinline__ void done(const Unit&) const {}
};
struct EpiGateAtomic {
    static constexpr bool PERM = false, AFTER_DRAIN = false;
    float* out; const float* gate;
    __device__ __forceinline__ void operator()(const f32x4 (&acc)[2][2][4][2], const Unit& u, int wr, int wc, int fr, int fq) const {
        const int col0 = u.pn * BM + wc * 32 + 4 * fq;
#pragma unroll
        for (int bj = 0; bj < 2; ++bj)
#pragma unroll
            for (int n = 0; n < 2; ++n) { const f32x4 gv = *(const f32x4*)(gate + col0 + bj * HALF + n * 16);
#pragma unroll
                for (int ai = 0; ai < 2; ++ai)
#pragma unroll
                    for (int m = 0; m < 4; ++m) { float* o = out + (size_t)(ai * HALF + wr * 64 + m * 16 + fr) * 2048 + col0 + bj * HALF + n * 16; const f32x4 v = gv * acc[ai][bj][m][n];
                        __hip_atomic_fetch_add(o + 0, v.x, __ATOMIC_RELAXED, __HIP_MEMORY_SCOPE_AGENT); __hip_atomic_fetch_add(o + 1, v.y, __ATOMIC_RELAXED, __HIP_MEMORY_SCOPE_AGENT);
                        __hip_atomic_fetch_add(o + 2, v.z, __ATOMIC_RELAXED, __HIP_MEMORY_SCOPE_AGENT); __hip_atomic_fetch_add(o + 3, v.w, __ATOMIC_RELAXED, __HIP_MEMORY_SCOPE_AGENT); } }
    }
};
struct EpiConvGate {
    static constexpr bool PERM = true, AFTER_DRAIN = false;
    bf16_t* A2; bf16_t* U; const float* cw; const float* cb; int row_off;
    __device__ __forceinline__ void operator()(const f32x4 (&acc)[2][2][4][2], const Unit& u, int wr, int wc, int fr, int fq) const {
        const int lane = fq * 16 + fr;
        const int src_prev = fr > 0 ? lane - 1 : lane + 15, src_next = fr < 15 ? lane + 1 : lane - 15;
        const int ch0 = u.pn * 128 + wc * 32 + 8 * fq;
        const size_t urow0 = (size_t)row_off + (size_t)u.pm * BM + wr * 64 + fr;
#pragma unroll
        for (int n = 0; n < 2; ++n) {
            const int ch = ch0 + 4 * n;
            const f32x4 wa0 = *(const f32x4*)(cw + ch), wa1 = *(const f32x4*)(cw + 11264 + ch), wa2 = *(const f32x4*)(cw + 2 * 11264 + ch), ba = *(const f32x4*)(cb + ch);
            const f32x4 wg0 = *(const f32x4*)(cw + 5632 + ch), wg1 = *(const f32x4*)(cw + 11264 + 5632 + ch), wg2 = *(const f32x4*)(cw + 2 * 11264 + 5632 + ch), bg = *(const f32x4*)(cb + 5632 + ch);
#pragma unroll
            for (int ai = 0; ai < 2; ++ai)
#pragma unroll
                for (int m = 0; m < 4; ++m) {
                    const f32x4 ca = acc[ai][0][m][n], cg = acc[ai][1][m][n];
                    const f32x4 pa_src = (m > 0 && fr == 15) ? acc[ai][0][m > 0 ? m - 1 : 0][n] : ca, pg_src = (m > 0 && fr == 15) ? acc[ai][1][m > 0 ? m - 1 : 0][n] : cg;
                    const f32x4 na_src = (m < 3 && fr == 0) ? acc[ai][0][m < 3 ? m + 1 : 3][n] : ca, ng_src = (m < 3 && fr == 0) ? acc[ai][1][m < 3 ? m + 1 : 3][n] : cg;
                    f32x4 pa, pg, na, ng;
#pragma unroll
                    for (int e = 0; e < 4; ++e) { pa[e] = __shfl(pa_src[e], src_prev); pg[e] = __shfl(pg_src[e], src_prev); na[e] = __shfl(na_src[e], src_next); ng[e] = __shfl(ng_src[e], src_next); }
                    const size_t ur = urow0 + ai * HALF + m * 16;
                    const bool deferred = (m == 0 && fr == 0) || (m == 3 && fr == 15);
                    const bool raw = (m == 0 && fr <= 1) || (m == 3 && fr >= 14);
                    if (raw) { u32x2_t w; w.x = cvt_pk_bf16(ca[0], ca[1]); w.y = cvt_pk_bf16(ca[2], ca[3]); *(u32x2_t*)(U + ur * 11264 + ch) = w;
                               w.x = cvt_pk_bf16(cg[0], cg[1]); w.y = cvt_pk_bf16(cg[2], cg[3]); *(u32x2_t*)(U + ur * 11264 + 5632 + ch) = w; }
                    if (!deferred) {
                        const f32x4 oa = ba + pa * wa0 + ca * wa1 + na * wa2, og = bg + pg * wg0 + cg * wg1 + ng * wg2;
                        f32x4 y;
#pragma unroll
                        for (int e = 0; e < 4; ++e) y[e] = og[e] * __builtin_amdgcn_rcpf(1.f + __expf(-og[e])) * oa[e];
                        u32x2_t w; w.x = cvt_pk_bf16(y[0], y[1]); w.y = cvt_pk_bf16(y[2], y[3]);
                        *(u32x2_t*)(A2 + ur * 5632 + ch) = w;
                    }
                }
        }
    }
};
template <int LAYER> struct EpiQKV {
    static constexpr bool PERM = true, AFTER_DRAIN = false;
    bf16_t* P; const float* gtab; PG8_LAS float* part;
    __device__ __forceinline__ void operator()(const f32x4 (&acc)[2][2][4][2], const Unit& u, int wr, int wc, int fr, int fq) const {
        const int pn = u.pn;
        bool plain, w64, rope; const float* g;
        if (LAYER == 0) { plain = (pn >= 8 && pn < 12) || pn == 17; w64 = pn < 8; rope = true; g = gtab + (pn < 4 ? 0 : 64) + (pn < 8 ? 0 : 64) + (pn < 16 ? 0 : 128); }
        else            { plain = pn == 5 || pn >= 14; w64 = false; rope = pn < 5; g = gtab + (pn < 4 ? 0 : 128) + (pn < 5 ? 0 : 128) + (pn < 10 ? 0 : 128); }
        const int row0 = u.pm * BM + wr * 64 + fr, colw = wc * 32 + 8 * fq;
        bf16_t* base = P + (size_t)row0 * 4608 + (size_t)pn * BM + colw;
        if (plain) {
#pragma unroll
            for (int ai = 0; ai < 2; ++ai)
#pragma unroll
                for (int m = 0; m < 4; ++m)
#pragma unroll
                    for (int bj = 0; bj < 2; ++bj) { const f32x4 v0 = acc[ai][bj][m][0], v1 = acc[ai][bj][m][1];
                        u32x4 w; w.x = cvt_pk_bf16(v0[0], v0[1]); w.y = cvt_pk_bf16(v0[2], v0[3]); w.z = cvt_pk_bf16(v1[0], v1[1]); w.w = cvt_pk_bf16(v1[2], v1[3]);
                        *(u32x4*)(base + (size_t)(ai * HALF + m * 16) * 4608 + bj * HALF) = w; }
            return;
        }
        const bool latent = u.pm > 0;
        PG8_LAS float* pw = part + (wr * 64 + fr) * 8 + wc; const PG8_LAS float* prd = part + (wr * 64 + fr) * 8;
#pragma unroll
        for (int ai = 0; ai < 2; ++ai)
#pragma unroll
            for (int m = 0; m < 4; ++m)
#pragma unroll
                for (int bj = 0; bj < 2; ++bj) { const f32x4 v0 = acc[ai][bj][m][0], v1 = acc[ai][bj][m][1];
                    float s = (v0[0] * v0[0] + v0[1] * v0[1]) + (v0[2] * v0[2] + v0[3] * v0[3]) + (v1[0] * v1[0] + v1[1] * v1[1]) + (v1[2] * v1[2] + v1[3] * v1[3]);
                    s += __shfl_xor(s, 16); s += __shfl_xor(s, 32);
                    if (fq == 0) pw[(ai * HALF + m * 16) * 8 + bj * 4] = s; }
        asm volatile("s_waitcnt lgkmcnt(0)" ::: "memory"); __builtin_amdgcn_s_barrier(); asm volatile("" ::: "memory");
        const int jh = w64 ? ((wc & 1) * 32 + 8 * fq) : colw;
        int dh = jh;
        if (!w64 && rope) { const int b = jh >> 4, bo = (b == 1 || b == 5) ? b + 1 : (b == 2 || b == 6) ? b - 1 : b; dh = bo * 16 + (jh & 15); }
        const f32x4 ga = *(const f32x4*)(g + dh), gb = *(const f32x4*)(g + dh + 4);
        const float gg[8] = {ga[0], ga[1], ga[2], ga[3], gb[0], gb[1], gb[2], gb[3]};
        const bool first = fq < 2;
        const bool colpos = w64 ? (wc & 1) : (wc >> 1);
        float fr8[8];
        { const int i0 = (w64 ? 0 : 16 * (wc & 1)) + 8 * (fq & 1); const float fstep = w64 ? (-13.287712379549449f / 16.f) : (-13.287712379549449f / 32.f);
#pragma unroll
          for (int e8 = 0; e8 < 8; ++e8) fr8[e8] = __builtin_amdgcn_exp2f((float)(i0 + e8) * fstep); }
        const float invw = w64 ? (1.f / 64.f) : (1.f / 128.f);
#pragma unroll
        for (int ai = 0; ai < 2; ++ai)
#pragma unroll
            for (int m = 0; m < 4; ++m) {
                const int rl = ai * HALF + wr * 64 + m * 16 + fr;
                const int tpos = u.pm * BM + rl - 256;
                const float pos = (float)(colpos ? (tpos & 63) : (tpos >> 6));
#pragma unroll
                for (int bj = 0; bj < 2; ++bj) {
                    const PG8_LAS float* pp = prd + (ai * HALF + m * 16) * 8 + bj * 4;
                    const float ssum = w64 ? (pp[wc & 2] + pp[(wc & 2) + 1]) : ((pp[0] + pp[1]) + (pp[2] + pp[3]));
                    const float rstd = __builtin_amdgcn_rsqf(ssum * invw + 1e-6f);
                    const f32x4 v0 = acc[ai][bj][m][0], v1 = acc[ai][bj][m][1];
                    float x[8] = {v0[0], v0[1], v0[2], v0[3], v1[0], v1[1], v1[2], v1[3]};
#pragma unroll
                    for (int e8 = 0; e8 < 8; ++e8) x[e8] = x[e8] * rstd * gg[e8];
                    if (rope) {
#pragma unroll
                        for (int e8 = 0; e8 < 8; ++e8) { const float other = __shfl_xor(x[e8], 32);
                            const float ang = pos * fr8[e8]; const float cs = __cosf(ang), sn = __sinf(ang);
                            const float rot = first ? x[e8] * cs - other * sn : x[e8] * cs + other * sn;
                            x[e8] = latent ? rot : x[e8]; }
                    }
                    u32x4 w; w.x = cvt_pk_bf16(x[0], x[1]); w.y = cvt_pk_bf16(x[2], x[3]); w.z = cvt_pk_bf16(x[4], x[5]); w.w = cvt_pk_bf16(x[6], x[7]);
                    *(u32x4*)(base + (size_t)(ai * HALF + m * 16) * 4608 + bj * HALF) = w;
                    asm volatile("" ::: "memory");
                }
            }
    }
};
template <class Epi, class Sched, bool ALIGN_EPI = false, bool SP2 = false>
__device__ __forceinline__ void gemm_phase(PG8_LAS unsigned char* lds, const Gemm g, const Sched& S, const Epi& E) {
    int tid_ = threadIdx.x; asm volatile("" : "+v"(tid_)); const int tid = tid_, wid = __builtin_amdgcn_readfirstlane(tid >> 6), lane = tid & 63, wr = wid >> 2, wc = wid & 3, fr = lane & 15, fq = lane >> 4;
    const int K = g.ld, nt = g.K / BK;
    unsigned voffA[2], voffB[2];
#pragma unroll
    for (int i = 0; i < 2; ++i) { int R, C; stage_rc(tid * 16 + i * 8192, R, C); const int Rb = Epi::PERM ? ((R & ~31) + perm32(R & 31)) : R;
        voffA[i] = (unsigned)(R * K + C) * 2u; voffB[i] = (unsigned)(Rb * K + C) * 2u; }
    const size_t kstep = (size_t)(BK * 2);
    const size_t hstep = (size_t)HALF * K * 2;
    const size_t tstep = 2 * hstep;
    const unsigned ldsw = (unsigned)wid * 1024u;
    const int aoff = lds_byte(wr * 64 + fr, fq * 8), boff = lds_byte(wc * 32 + fr, fq * 8);
#define PG8_SA(b, h) (((b) * 2 + (h)) * HTB)
#define PG8_SB(b, h) ((4 + (b) * 2 + (h)) * HTB)
#define PG8_STAGE(bufoff, gbase, voff) do { _Pragma("unroll") for (int _i = 0; _i < 2; ++_i) \
        __builtin_amdgcn_global_load_lds((const unsigned*)((const char*)(gbase) + (voff)[_i]), (PG8_LAS unsigned*)(lds + (bufoff) + ldsw + _i * 8192), 16, 0, 0); } while (0)
#define PG8_LDA(dst, b, h) do { _Pragma("unroll") for (int m = 0; m < 4; ++m) _Pragma("unroll") for (int k = 0; k < 2; ++k) dst[m][k] = *(const PG8_LAS bf16x8*)(lds + PG8_SA(b, h) + aoff + m * 2048 + k * 1024); } while (0)
#define PG8_LDB(dst, b, h) do { _Pragma("unroll") for (int n = 0; n < 2; ++n) _Pragma("unroll") for (int k = 0; k < 2; ++k) dst[n][k] = *(const PG8_LAS bf16x8*)(lds + PG8_SB(b, h) + boff + n * 2048 + k * 1024); } while (0)
#define PG8_MMA(ai, bj, At, Bt) do { __builtin_amdgcn_s_setprio(1); _Pragma("unroll") for (int m = 0; m < 4; ++m) _Pragma("unroll") for (int n = 0; n < 2; ++n) _Pragma("unroll") for (int k = 0; k < 2; ++k) \
        acc[ai][bj][m][n] = __builtin_amdgcn_mfma_f32_16x16x32_bf16(Bt[n][k], At[m][k], acc[ai][bj][m][n], 0, 0, 0); __builtin_amdgcn_s_setprio(0); } while (0)
#define PG8_WAIT_V(n) asm volatile("s_waitcnt vmcnt(" #n ")" ::: "memory")
#define PG8_WAIT_L(n) asm volatile("s_waitcnt lgkmcnt(" #n ")" ::: "memory")
#define PG8_BAR __builtin_amdgcn_s_barrier()
#define PG8_SCHED __builtin_amdgcn_sched_barrier(0)
    Unit cur, nxt; int ui = 0;
    if (!S.next(0, cur)) return;
    f32x4 acc[2][2][4][2];
#pragma unroll
    for (int a = 0; a < 2; ++a)
#pragma unroll
        for (int b = 0; b < 2; ++b)
#pragma unroll
            for (int m = 0; m < 4; ++m)
#pragma unroll
                for (int n = 0; n < 2; ++n) acc[a][b][m][n] = (f32x4){0.f, 0.f, 0.f, 0.f};
    bf16x8 At[4][2], B0[2][2], B1[2][2];
    const char* cA = (const char*)g.A + (size_t)cur.pm * tstep + (size_t)cur.k0 * 2; const char* cB = (const char*)g.Bt + (size_t)cur.pn * tstep + (size_t)cur.k0 * 2;
    S.a_ready(cur);
    if constexpr (SP2) {
        PG8_STAGE(PG8_SB(0, 0), cB, voffB); PG8_STAGE(PG8_SB(0, 1), cB + hstep, voffB); PG8_STAGE(PG8_SA(0, 0), cA, voffA); PG8_STAGE(PG8_SA(0, 1), cA + hstep, voffA);
        if (wr == 1) PG8_BAR;
        PG8_WAIT_V(2); PG8_BAR;
        PG8_STAGE(PG8_SB(1, 0), cB + kstep, voffB); PG8_STAGE(PG8_SA(1, 0), cA + kstep, voffA); PG8_STAGE(PG8_SB(1, 1), cB + hstep + kstep, voffB);
        PG8_WAIT_V(6); PG8_BAR;
    } else {
        PG8_STAGE(PG8_SB(0, 0), cB, voffB); PG8_STAGE(PG8_SA(0, 0), cA, voffA); PG8_STAGE(PG8_SB(0, 1), cB + hstep, voffB); PG8_STAGE(PG8_SA(0, 1), cA + hstep, voffA);
        if (wr == 1) PG8_BAR;
        PG8_WAIT_V(4); PG8_BAR;
        PG8_STAGE(PG8_SB(1, 0), cB + kstep, voffB); PG8_STAGE(PG8_SA(1, 0), cA + kstep, voffA); PG8_STAGE(PG8_SB(1, 1), cB + hstep + kstep, voffB);
        PG8_WAIT_V(6); PG8_BAR;
    }
    for (;;) {
        const bool has_next = S.next(ui + 1, nxt);
        const char* nA = has_next ? (const char*)g.A + (size_t)nxt.pm * tstep + (size_t)nxt.k0 * 2 : cA; const char* nB = has_next ? (const char*)g.Bt + (size_t)nxt.pn * tstep + (size_t)nxt.k0 * 2 : cB;
        for (int t = 0; t < nt; t += 2) {
            const bool last = (t == nt - 2);
            const char* a1 = cA + (size_t)(t + 1) * kstep;
            const char* a2 = last ? nA : cA + (size_t)(t + 2) * kstep; const char* b2 = last ? nB : cB + (size_t)(t + 2) * kstep;
            const char* a3 = a2 + kstep; const char* b3 = b2 + kstep;
            if (last && has_next) S.a_ready(nxt);
            if constexpr (SP2) {
            PG8_LDB(B0, 0, 0); PG8_LDB(B1, 0, 1); PG8_SCHED; PG8_LDA(At, 0, 0); PG8_STAGE(PG8_SA(1, 1), a1 + hstep, voffA);
            PG8_WAIT_V(8); PG8_WAIT_L(0); PG8_BAR; PG8_MMA(0, 0, At, B0); PG8_MMA(0, 1, At, B1); PG8_BAR; PG8_SCHED;
            PG8_LDA(At, 0, 1); PG8_STAGE(PG8_SB(0, 0), b2, voffB); PG8_STAGE(PG8_SB(0, 1), b2 + hstep, voffB); PG8_STAGE(PG8_SA(0, 0), a2, voffA);
            PG8_WAIT_V(8); PG8_WAIT_L(0); PG8_BAR; PG8_MMA(1, 0, At, B0); PG8_MMA(1, 1, At, B1); PG8_BAR; PG8_SCHED;
            PG8_LDB(B0, 1, 0); PG8_LDB(B1, 1, 1); PG8_SCHED; PG8_LDA(At, 1, 0); PG8_STAGE(PG8_SA(0, 1), a2 + hstep, voffA);
            PG8_WAIT_V(8); PG8_WAIT_L(0); PG8_BAR; PG8_MMA(0, 0, At, B0); PG8_MMA(0, 1, At, B1); PG8_BAR; PG8_SCHED;
            PG8_LDA(At, 1, 1); PG8_STAGE(PG8_SB(1, 0), b3, voffB); PG8_STAGE(PG8_SB(1, 1), b3 + hstep, voffB); PG8_STAGE(PG8_SA(1, 0), a3, voffA);
            PG8_WAIT_V(8); PG8_WAIT_L(0); PG8_BAR; PG8_MMA(1, 0, At, B0); PG8_MMA(1, 1, At, B1); PG8_BAR; PG8_SCHED;
            } else {
            PG8_LDB(B0, 0, 0); PG8_SCHED; PG8_LDA(At, 0, 0); PG8_STAGE(PG8_SA(1, 1), a1 + hstep, voffA);
            PG8_WAIT_L(8); PG8_BAR; PG8_WAIT_L(0); PG8_MMA(0, 0, At, B0); PG8_BAR; PG8_SCHED;
            PG8_LDB(B1, 0, 1); PG8_STAGE(PG8_SB(0, 0), b2, voffB);
            PG8_BAR; PG8_WAIT_L(0); PG8_MMA(0, 1, At, B1); PG8_BAR;
            PG8_LDA(At, 0, 1); PG8_STAGE(PG8_SA(0, 0), a2, voffA);
            PG8_BAR; PG8_WAIT_L(0); PG8_MMA(1, 0, At, B0); PG8_BAR; PG8_SCHED;
            PG8_STAGE(PG8_SB(0, 1), b2 + hstep, voffB);
            PG8_WAIT_V(6); PG8_BAR; PG8_MMA(1, 1, At, B1); PG8_BAR;
            PG8_LDB(B0, 1, 0); PG8_SCHED; PG8_LDA(At, 1, 0); PG8_STAGE(PG8_SA(0, 1), a2 + hstep, voffA);
            PG8_WAIT_L(8); PG8_BAR; PG8_WAIT_L(0); PG8_MMA(0, 0, At, B0); PG8_BAR; PG8_SCHED;
            PG8_LDB(B1, 1, 1); PG8_STAGE(PG8_SB(1, 0), b3, voffB);
            PG8_BAR; PG8_WAIT_L(0); PG8_MMA(0, 1, At, B1); PG8_BAR;
            PG8_LDA(At, 1, 1); PG8_STAGE(PG8_SA(1, 0), a3, voffA);
            PG8_BAR; PG8_WAIT_L(0); PG8_MMA(1, 0, At, B0); PG8_BAR; PG8_SCHED;
            PG8_STAGE(PG8_SB(1, 1), b3 + hstep, voffB);
            PG8_WAIT_V(6); PG8_BAR; PG8_MMA(1, 1, At, B1); PG8_BAR;
            }
        }
        if constexpr (ALIGN_EPI) { if (wr == 0) PG8_BAR; }
        if constexpr (!Epi::AFTER_DRAIN) { E(acc, cur, wr, wc, fr, fq); S.done(cur); }
        if (!has_next) break;
#pragma unroll
        for (int a = 0; a < 2; ++a)
#pragma unroll
            for (int b = 0; b < 2; ++b)
#pragma unroll
                for (int m = 0; m < 4; ++m)
#pragma unroll
                    for (int n = 0; n < 2; ++n) acc[a][b][m][n] = (f32x4){0.f, 0.f, 0.f, 0.f};
        cur = nxt; cA = nA; cB = nB; ++ui;
        if constexpr (ALIGN_EPI) { if (wr == 1) PG8_BAR; }
    }
    PG8_WAIT_V(0);
    if constexpr (!ALIGN_EPI) { if (wr == 0) PG8_BAR; }
    PG8_BAR;
    if constexpr (Epi::AFTER_DRAIN) { E.fused(acc, cur, wr, wc, fr, fq, lds, wid, lane); S.done(cur); }
#undef PG8_SA
#undef PG8_SB
#undef PG8_STAGE
#undef PG8_LDA
#undef PG8_LDB
#undef PG8_MMA
#undef PG8_WAIT_V
#undef PG8_WAIT_L
#undef PG8_BAR
#undef PG8_SCHED
}
}
namespace att {
using bf16 = __hip_bfloat16;
using bf16x8 = __attribute__((ext_vector_type(8))) short;
using s16x4  = __attribute__((ext_vector_type(4))) short;
using f32x16 = __attribute__((ext_vector_type(16))) float;
using u32x4  = __attribute__((ext_vector_type(4))) unsigned;
constexpr int LDP = 4608;
constexpr int LDY = 2048;
constexpr int SHM_V = 64 * 128 * 2, SHM_K = 64 * 128 * 2;
constexpr int NSLOT = 3;
constexpr int OFF_Q = 2 * SHM_V + 2 * SHM_K;
constexpr int OFF_WS = 131072, OFF_TAB = OFF_WS + 8 * 64 * 4, ATT_LDS = OFF_TAB + 2048;
constexpr float THR = 8.f;


#define SBAR() __builtin_amdgcn_sched_barrier(0)
__device__ __forceinline__ int crow(int r, int hi) { return (r & 3) + 8 * (r >> 2) + 4 * hi; }
__device__ __forceinline__ unsigned cvtpk(float lo, float hi) { unsigned r; asm volatile("v_cvt_pk_bf16_f32 %0, %1, %2" : "=v"(r) : "v"(lo), "v"(hi)); return r; }
__device__ __forceinline__ bf16x8 ld8(const bf16* p) { return *reinterpret_cast<const bf16x8*>(p); }
template <int DQK> __device__ __forceinline__ int kswz(int row, int colB) {
  if constexpr (DQK == 128) return row * 256 + (colB ^ ((((row & 7) | (((row >> 4) & 1) << 3))) << 4));
  else return row * 128 + (colB ^ (((((row >> 1) & 3) | (((row >> 4) & 1) << 2))) << 4));
}

template <int DQK> __device__ __forceinline__ void partialSM(f32x16& p0, f32x16& p1, float& m_reg, float& mn, float& alpha) {
  constexpr float SCALE = (DQK == 128) ? 0.088388347648318440f : 0.125f;
  constexpr float C = SCALE * 1.4426950408889634f;
  float pmax = p0[0];
#pragma unroll
  for (int r = 1; r < 16; ++r) pmax = fmaxf(pmax, p0[r]);
#pragma unroll
  for (int r = 0; r < 16; ++r) pmax = fmaxf(pmax, p1[r]);
  { auto rr = __builtin_amdgcn_permlane32_swap(__float_as_uint(pmax), __float_as_uint(pmax), false, false);
    pmax = fmaxf(__uint_as_float(rr[0]), __uint_as_float(rr[1])); }
  if (__builtin_expect(__all(pmax - m_reg <= THR / SCALE), 1)) { mn = m_reg; alpha = 1.f; }
  else { mn = fmaxf(m_reg, pmax); alpha = __builtin_amdgcn_exp2f((m_reg - mn) * C); m_reg = mn; }
  float mnC = -mn * C;
#pragma unroll
  for (int r = 0; r < 16; ++r) p0[r] = fmaf(p0[r], C, mnC);
#pragma unroll
  for (int r = 0; r < 16; ++r) p1[r] = fmaf(p1[r], C, mnC);
#pragma unroll
  for (int r = 0; r < 16; ++r) p0[r] = __builtin_amdgcn_exp2f(p0[r]);
}
__device__ __forceinline__ void finishSM(f32x16& p0, f32x16& p1, float alpha, float& l_reg, bf16x8& pa0, bf16x8& pa1, bf16x8& pa2, bf16x8& pa3) {
#pragma unroll
  for (int r = 0; r < 16; ++r) p1[r] = __builtin_amdgcn_exp2f(p1[r]);
  float ps = 0;
#pragma unroll
  for (int r = 0; r < 16; ++r) ps += p0[r];
#pragma unroll
  for (int r = 0; r < 16; ++r) ps += p1[r];
  { auto rr = __builtin_amdgcn_permlane32_swap(__float_as_uint(ps), __float_as_uint(ps), false, false);
    ps = __uint_as_float(rr[0]) + __uint_as_float(rr[1]); }
  l_reg = l_reg * alpha + ps;
#define PK4(P, BASE, OUT) do { unsigned a0 = cvtpk(P[BASE + 0], P[BASE + 1]), a1 = cvtpk(P[BASE + 2], P[BASE + 3]);   \
    unsigned b0 = cvtpk(P[BASE + 4], P[BASE + 5]), b1 = cvtpk(P[BASE + 6], P[BASE + 7]);                              \
    auto r0 = __builtin_amdgcn_permlane32_swap(a0, b0, false, false); auto r1 = __builtin_amdgcn_permlane32_swap(a1, b1, false, false); \
    u32x4 w = {r0[0], r1[0], r0[1], r1[1]}; OUT = *reinterpret_cast<bf16x8*>(&w); } while (0)
  PK4(p0, 0, pa0); PK4(p0, 8, pa1); PK4(p1, 0, pa2); PK4(p1, 8, pa3);
#undef PK4
}
template <int DQK, bool QREG> __device__ __forceinline__ void qkt(f32x16& p0, f32x16& p1, const bf16* Ks, const bf16x8* qr, const char* Qimg, int r32, int hi) {
  p0 = f32x16{}; p1 = f32x16{};
#pragma unroll
  for (int d0 = 0; d0 < DQK / 16; ++d0) { int cb = (d0 * 16 + hi * 8) * 2;
    bf16x8 q; if constexpr (QREG) q = qr[d0]; else q = *reinterpret_cast<const bf16x8*>(Qimg + d0 * 1024);
    bf16x8 b0 = *reinterpret_cast<const bf16x8*>((const char*)Ks + kswz<DQK>(r32, cb));
    bf16x8 b1 = *reinterpret_cast<const bf16x8*>((const char*)Ks + kswz<DQK>(32 + r32, cb));
    p0 = __builtin_amdgcn_mfma_f32_32x32x16_bf16(b0, q, p0, 0, 0, 0);
    p1 = __builtin_amdgcn_mfma_f32_32x32x16_bf16(b1, q, p1, 0, 0, 0); }
}
__device__ __forceinline__ int v_st(int k, int c) { const int kk = (k & ~0xC) | ((k & 4) << 1) | ((k & 8) >> 1); return ((kk >> 3) * 4 + (c >> 5)) * 512 + ((kk & 7) * 32 + (c & 31)) * 2; }
__device__ __forceinline__ int v_rd_base(int lane) { return ((lane & 3) << 3) | (((lane >> 2) & 3) << 6) | (((lane >> 4) & 1) << 5) | (((lane >> 5) & 1) << 8); }
constexpr int v_rd_off(int d0, int ks, int half) { return d0 * 512 + ks * 4096 + half * 2048; }
template <int OFF> __device__ __forceinline__ s16x4 tr_read(int vb) {
  s16x4 r; asm volatile("ds_read_b64_tr_b16 %0, %1 offset:%2" : "=&v"(r) : "v"(vb), "i"(OFF) : "memory"); return r;
}
template <int D0> __device__ __forceinline__ void pv_one(f32x16& od, int vb, bf16x8 pa0, bf16x8 pa1, bf16x8 pa2, bf16x8 pa3) {
  const s16x4 l0 = tr_read<v_rd_off(D0, 0, 0)>(vb), h0 = tr_read<v_rd_off(D0, 0, 1)>(vb), l1 = tr_read<v_rd_off(D0, 1, 0)>(vb), h1 = tr_read<v_rd_off(D0, 1, 1)>(vb);
  const s16x4 l2 = tr_read<v_rd_off(D0, 2, 0)>(vb), h2 = tr_read<v_rd_off(D0, 2, 1)>(vb), l3 = tr_read<v_rd_off(D0, 3, 0)>(vb), h3 = tr_read<v_rd_off(D0, 3, 1)>(vb);
  asm volatile("s_waitcnt lgkmcnt(0)" ::: "memory"); SBAR();
#define PK(L, H) (bf16x8){L[0], L[1], L[2], L[3], H[0], H[1], H[2], H[3]}
  od = __builtin_amdgcn_mfma_f32_32x32x16_bf16(pa0, PK(l0, h0), od, 0, 0, 0);
  od = __builtin_amdgcn_mfma_f32_32x32x16_bf16(pa1, PK(l1, h1), od, 0, 0, 0);
  od = __builtin_amdgcn_mfma_f32_32x32x16_bf16(pa2, PK(l2, h2), od, 0, 0, 0);
  od = __builtin_amdgcn_mfma_f32_32x32x16_bf16(pa3, PK(l3, h3), od, 0, 0, 0);
#undef PK
}
__device__ __forceinline__ void pv_d0(f32x16* o, int vb, bf16x8 pa0, bf16x8 pa1, bf16x8 pa2, bf16x8 pa3) {
  pv_one<0>(o[0], vb, pa0, pa1, pa2, pa3); pv_one<1>(o[1], vb, pa0, pa1, pa2, pa3); pv_one<2>(o[2], vb, pa0, pa1, pa2, pa3); pv_one<3>(o[3], vb, pa0, pa1, pa2, pa3);
}

__device__ __forceinline__ void glds16(const void* gsrc, unsigned lds_dst) { unsigned keep;
  asm volatile("s_mov_b32 %0, m0\n\ts_mov_b32 m0, %2\n\ts_nop 0\n\tglobal_load_lds_dwordx4 %1, off\n\ts_mov_b32 m0, %0" : "=&s"(keep) : "v"(gsrc), "s"(lds_dst) : "memory"); }
struct MaskCtx { int a, b, c; const float* tab; };
template <int MODE> __device__ __forceinline__ void apply_mask(f32x16& p0, f32x16& p1, int j, const MaskCtx& mc, int hi) {
  if constexpr (MODE == 0) return;
  if (j < 4) return;
  if constexpr (MODE == 1) {
    const int kt0 = mc.b + (j - 4) * 64;
#pragma unroll
    for (int r = 0; r < 16; ++r) {
      const int k0 = kt0 + crow(r, hi), k1 = k0 + 32;
      const int d0 = mc.a - k0, d1 = mc.a - k1;
      const bool v0 = (d0 <= 128) && (d0 >= -128) && (k0 >= 0) && (k0 < 8192);
      const bool v1 = (d1 <= 128) && (d1 >= -128) && (k1 >= 0) && (k1 < 8192);
      p0[r] = v0 ? p0[r] : -1e30f; p1[r] = v1 ? p1[r] : -1e30f;
    }
  } else if constexpr (MODE == 2) {
    const int kr = mc.c + (j - 4);
    const int rs = min(max(mc.a - 4, 0), 120);
    const bool rv = (kr >= rs) && (kr < rs + 8);
    const int cs = min(max(mc.b - 8, 0), 48);
    const int tb = (rv ? (kr - mc.a + 7) : 7) * 31 - mc.b + 15;
#pragma unroll
    for (int r = 0; r < 16; ++r) {
      const int c0 = crow(r, hi), c1 = c0 + 32;
      const bool v0 = rv && (c0 >= cs) && (c0 < cs + 16);
      const bool v1 = rv && (c1 >= cs) && (c1 < cs + 16);
      const float b0 = mc.tab[v0 ? tb + c0 : 0], b1 = mc.tab[v1 ? tb + c1 : 0];
      p0[r] = v0 ? p0[r] + b0 : -1e30f; p1[r] = v1 ? p1[r] + b1 : -1e30f;
    }
  }
}

template <int DQK, int MODE>
__device__ __forceinline__ void pv_partial(f32x16* o, int vb, bf16x8 pa0, bf16x8 pa1, bf16x8 pa2, bf16x8 pa3, f32x16& p0, f32x16& p1, float& m_reg, float& mn, float& alpha, int j, const MaskCtx& mc, int hi) {
  constexpr float SCALE = (DQK == 128) ? 0.088388347648318440f : 0.125f;
  constexpr float C = SCALE * 1.4426950408889634f;
  apply_mask<MODE>(p0, p1, j, mc, hi);
  pv_one<0>(o[0], vb, pa0, pa1, pa2, pa3);
  float pm0 = p0[0];
#pragma unroll
  for (int r = 1; r < 16; ++r) pm0 = fmaxf(pm0, p0[r]);
  SBAR();
  pv_one<1>(o[1], vb, pa0, pa1, pa2, pa3);
  float pmax = pm0;
#pragma unroll
  for (int r = 0; r < 16; ++r) pmax = fmaxf(pmax, p1[r]);
  { auto rr = __builtin_amdgcn_permlane32_swap(__float_as_uint(pmax), __float_as_uint(pmax), false, false);
    pmax = fmaxf(__uint_as_float(rr[0]), __uint_as_float(rr[1])); }
  if (__builtin_expect(__all(pmax - m_reg <= THR / SCALE), 1)) { mn = m_reg; alpha = 1.f; }
  else { mn = fmaxf(m_reg, pmax); alpha = __builtin_amdgcn_exp2f((m_reg - mn) * C); m_reg = mn; }
  const float mnC = -mn * C;
  SBAR();
  pv_one<2>(o[2], vb, pa0, pa1, pa2, pa3);
#pragma unroll
  for (int r = 0; r < 16; ++r) p0[r] = fmaf(p0[r], C, mnC);
#pragma unroll
  for (int r = 0; r < 16; ++r) p1[r] = fmaf(p1[r], C, mnC);
  SBAR();
  pv_one<3>(o[3], vb, pa0, pa1, pa2, pa3);
#pragma unroll
  for (int r = 0; r < 16; ++r) p0[r] = __builtin_amdgcn_exp2f(p0[r]);
}

template <int DQK, int MODE>
__device__ __forceinline__ void attn_core(const bf16* __restrict__ Qb, const bf16* __restrict__ Kh, const bf16* __restrict__ Vh, const int NT, const int band0,
                                          const MaskCtx& mc, char* lds, f32x16 (&o)[4], float& m_reg, float& l_reg) {
  int tid_ = threadIdx.x; asm volatile("" : "+v"(tid_));
  const int tid = tid_, wid = tid >> 6, lane = tid & 63, r32 = lane & 31, hi = lane >> 5;
  constexpr int NSL = (MODE == 0) ? NSLOT : 2;
  bf16* V_lds = (bf16*)lds; bf16* K_lds = (bf16*)(lds + NSL * SHM_V);
  float* ws = (float*)(lds + OFF_WS) + wid * 64; float* al_l = ws + 32;
  m_reg = -1e30f; l_reg = 0.f;
#pragma unroll
  for (int d = 0; d < 4; ++d) o[d] = f32x16{};
  constexpr bool QREG = (MODE == 0);
  constexpr int SDEPTH = (MODE == 0) ? 2 : 1;
  bf16x8 qr[DQK / 16];
  const bf16* Qw = Qb + (long)(wid * 32 + r32) * LDP + hi * 8;
#pragma unroll
  for (int d0 = 0; d0 < DQK / 16; ++d0) qr[d0] = ld8(Qw + d0 * 16);
  char* Qimg = lds + OFF_Q + wid * 8192 + lane * 16;
  const int sr = tid >> 4, sc = (tid & 15) * 8, vst0 = v_st(sr, sc), vst1 = v_st(32 + sr, sc);
  const int kr64 = tid >> 3, kc64 = (tid & 7) * 8;
  const int vb0 = (int)(uintptr_t)V_lds + v_rd_base(lane);
  struct { bf16x8 vs0, vs1, ks0, ks1; } sr_[SDEPTH];
#define TROW(j) ((MODE == 0 || (j) < 4) ? (j) * 64 : band0 + ((j) - 4) * 64)
  const unsigned offv0 = (unsigned)(sr * LDP + sc), offv1 = (unsigned)((32 + sr) * LDP + sc), offk64 = (unsigned)(kr64 * LDP + kc64);
#define SLOAD(i, j) do { const long k0_ = (long)TROW(j) * LDP; const bf16* vt_ = Vh + k0_; const bf16* kt_ = Kh + k0_; \
    sr_[i].vs0 = ld8(vt_ + offv0); sr_[i].vs1 = ld8(vt_ + offv1); \
    if constexpr (DQK == 128) { sr_[i].ks0 = ld8(kt_ + offv0); sr_[i].ks1 = ld8(kt_ + offv1); } \
    else { sr_[i].ks0 = ld8(kt_ + offk64); } } while (0)
#define SWRITE(so, i) do { *(bf16x8*)((char*)V_lds + (so) + vst0) = sr_[i].vs0; *(bf16x8*)((char*)V_lds + (so) + vst1) = sr_[i].vs1; \
    if constexpr (DQK == 128) { *(bf16x8*)((char*)K_lds + (so) + kswz<128>(sr, sc * 2)) = sr_[i].ks0; *(bf16x8*)((char*)K_lds + (so) + kswz<128>(32 + sr, sc * 2)) = sr_[i].ks1; } \
    else { *(bf16x8*)((char*)K_lds + (so) + kswz<64>(kr64, kc64 * 2)) = sr_[i].ks0; } } while (0)
#define SWAIT() do { if constexpr (SDEPTH == 2) asm volatile("s_waitcnt vmcnt(4)" ::: "memory"); else asm volatile("s_waitcnt vmcnt(0)" ::: "memory"); } while (0)
#define RESC(a) do { if (__any((a) < 1.f)) { if (hi == 0) al_l[r32] = (a); asm volatile("s_waitcnt lgkmcnt(0)" ::: "memory"); \
    _Pragma("unroll") for (int d = 0; d < 4; ++d) _Pragma("unroll") for (int r = 0; r < 16; ++r) o[d][r] *= al_l[crow(r, hi)]; } } while (0)
  f32x16 pA0, pA1, pB0, pB1; float mnA, mnB, alA, alB; bf16x8 pa0, pa1, pa2, pa3;
  if constexpr (MODE == 0) {
    const int widu = __builtin_amdgcn_readfirstlane(wid);
    constexpr int NKI = DQK / 64, NVI = 2;
    unsigned koff[NKI], voff[NVI];
#pragma unroll
    for (int i = 0; i < NKI; ++i) { const int p16 = (widu * NKI + i) * 64 + lane;
      if constexpr (DQK == 128) { const int row = p16 >> 4, slot = p16 & 15, f = (row & 7) | (((row >> 4) & 1) << 3); koff[i] = (unsigned)(row * LDP + ((slot ^ f) << 3)); }
      else                      { const int row = p16 >> 3, slot = p16 & 7,  f = ((row >> 1) & 3) | (((row >> 4) & 1) << 2); koff[i] = (unsigned)(row * LDP + ((slot ^ f) << 3)); } }
#pragma unroll
    for (int i = 0; i < NVI; ++i) { const int off = ((widu * NVI + i) * 64 + lane) * 16, sub = off >> 9, within = (off & 511) >> 1;
      const int kk = (sub >> 2) * 8 + (within >> 5), k = (kk & ~0xC) | ((kk & 4) << 1) | ((kk & 8) >> 1), c = (sub & 3) * 32 + (within & 31);
      voff[i] = (unsigned)(k * LDP + c); }
    const unsigned ldsV = (unsigned)(uintptr_t)V_lds + (unsigned)widu * (NVI * 1024u), ldsK = (unsigned)(uintptr_t)K_lds + (unsigned)widu * (NKI * 1024u);
#define DMA_TILE(jj, so) do { const long k0_ = (long)(jj) * 64 * LDP; const bf16* vt_ = Vh + k0_; const bf16* kt_ = Kh + k0_; \
    _Pragma("unroll") for (int i_ = 0; i_ < NKI; ++i_) glds16(kt_ + koff[i_], (unsigned)__builtin_amdgcn_readfirstlane(ldsK + (unsigned)(so) + i_ * 1024u)); \
    _Pragma("unroll") for (int i_ = 0; i_ < NVI; ++i_) glds16(vt_ + voff[i_], (unsigned)__builtin_amdgcn_readfirstlane(ldsV + (unsigned)(so) + i_ * 1024u)); } while (0)
#define VMWAIT0() asm volatile("s_waitcnt vmcnt(0)" ::: "memory")
#define RESCD(a) do { if (__any((a) < 1.f)) { if (hi == 0) al_l[r32] = (a); asm volatile("s_waitcnt lgkmcnt(0)" ::: "memory"); \
    _Pragma("unroll") for (int d = 0; d < 4; ++d) _Pragma("unroll") for (int r = 0; r < 16; ++r) o[d][r] *= al_l[crow(r, hi)]; } } while (0)
    int s_prev = 0, s_cur = SHM_V, s_next = 2 * SHM_V;
    __syncthreads();
    DMA_TILE(0, 0); VMWAIT0(); __syncthreads();
    DMA_TILE(1, SHM_V);
    qkt<DQK, true>(pA0, pA1, K_lds, qr, nullptr, r32, hi); partialSM<DQK>(pA0, pA1, m_reg, mnA, alA);
    VMWAIT0(); __syncthreads();
    for (int j = 1; j + 1 < NT; j += 2) {
      DMA_TILE(j + 1, s_next);
      SBAR(); qkt<DQK, true>(pB0, pB1, (bf16*)((char*)K_lds + s_cur), qr, nullptr, r32, hi);
      finishSM(pA0, pA1, alA, l_reg, pa0, pa1, pa2, pa3); SBAR();
      pv_partial<DQK, 0>(o, vb0 + s_prev, pa0, pa1, pa2, pa3, pB0, pB1, m_reg, mnB, alB, j, mc, hi);
      RESCD(alB); VMWAIT0(); __syncthreads();
      { const int t_ = s_prev; s_prev = s_cur; s_cur = s_next; s_next = t_; }
      if (j + 2 < NT) DMA_TILE(j + 2, s_next);
      SBAR(); qkt<DQK, true>(pA0, pA1, (bf16*)((char*)K_lds + s_cur), qr, nullptr, r32, hi);
      finishSM(pB0, pB1, alB, l_reg, pa0, pa1, pa2, pa3); SBAR();
      pv_partial<DQK, 0>(o, vb0 + s_prev, pa0, pa1, pa2, pa3, pA0, pA1, m_reg, mnA, alA, j + 1, mc, hi);
      RESCD(alA); VMWAIT0(); __syncthreads();
      { const int t_ = s_prev; s_prev = s_cur; s_cur = s_next; s_next = t_; }
    }
    SBAR(); qkt<DQK, true>(pB0, pB1, (bf16*)((char*)K_lds + s_cur), qr, nullptr, r32, hi);
    finishSM(pA0, pA1, alA, l_reg, pa0, pa1, pa2, pa3); SBAR();
    pv_partial<DQK, 0>(o, vb0 + s_prev, pa0, pa1, pa2, pa3, pB0, pB1, m_reg, mnB, alB, NT - 1, mc, hi);
    RESCD(alB);
    finishSM(pB0, pB1, alB, l_reg, pa0, pa1, pa2, pa3); SBAR();
    pv_d0(o, vb0 + s_cur, pa0, pa1, pa2, pa3);
#undef DMA_TILE
#undef VMWAIT0
#undef RESCD
    return;
  }
  constexpr int SE = 0, SO = SDEPTH - 1;
  int s_prev = 0, s_cur = SHM_V, s_next = (NSL == 3) ? 2 * SHM_V : 0;
#define ROT() do { const int t_ = s_prev; s_prev = s_cur; s_cur = s_next; s_next = (NSL == 3) ? t_ : s_prev; } while (0)
  __syncthreads();
  if constexpr (!QREG) {
#pragma unroll
    for (int d0 = 0; d0 < DQK / 16; ++d0) *reinterpret_cast<bf16x8*>(Qimg + d0 * 1024) = qr[d0];
    asm volatile("s_waitcnt lgkmcnt(0)" ::: "memory");
  }
  SLOAD(SE, 0); asm volatile("s_waitcnt vmcnt(0)" ::: "memory"); SWRITE(0, SE); __syncthreads();
  qkt<DQK, QREG>(pA0, pA1, K_lds, qr, Qimg, r32, hi); apply_mask<MODE>(pA0, pA1, 0, mc, hi); partialSM<DQK>(pA0, pA1, m_reg, mnA, alA);
  SLOAD(SO, 1); if constexpr (SDEPTH == 2) { if (2 < NT) SLOAD(SE, 2); }
  SWAIT(); SWRITE(SHM_V, SO); __syncthreads();
  for (int j = 1; j + 1 < NT; j += 2) {
    SBAR(); qkt<DQK, QREG>(pB0, pB1, (bf16*)((char*)K_lds + s_cur), qr, Qimg, r32, hi);
    finishSM(pA0, pA1, alA, l_reg, pa0, pa1, pa2, pa3); SBAR();
    SLOAD(SO, j + SDEPTH); SBAR();
    pv_partial<DQK, MODE>(o, vb0 + s_prev, pa0, pa1, pa2, pa3, pB0, pB1, m_reg, mnB, alB, j, mc, hi);
    if constexpr (NSL == 2) __syncthreads();
    SWAIT(); SWRITE(s_next, SE);
    RESC(alB); __syncthreads(); ROT();
    SBAR(); qkt<DQK, QREG>(pA0, pA1, (bf16*)((char*)K_lds + s_cur), qr, Qimg, r32, hi);
    finishSM(pB0, pB1, alB, l_reg, pa0, pa1, pa2, pa3); SBAR();
    if (SDEPTH == 1 || j + 3 < NT) SLOAD(SE, j + 1 + SDEPTH); SBAR();
    pv_partial<DQK, MODE>(o, vb0 + s_prev, pa0, pa1, pa2, pa3, pA0, pA1, m_reg, mnA, alA, j + 1, mc, hi);
    if constexpr (NSL == 2) __syncthreads();
    SWAIT(); SWRITE(s_next, SO);
    RESC(alA); __syncthreads(); ROT();
  }
  SBAR(); qkt<DQK, QREG>(pB0, pB1, (bf16*)((char*)K_lds + s_cur), qr, Qimg, r32, hi);
  finishSM(pA0, pA1, alA, l_reg, pa0, pa1, pa2, pa3); SBAR();
  pv_partial<DQK, MODE>(o, vb0 + s_prev, pa0, pa1, pa2, pa3, pB0, pB1, m_reg, mnB, alB, NT - 1, mc, hi);
  RESC(alB);
  finishSM(pB0, pB1, alB, l_reg, pa0, pa1, pa2, pa3); SBAR();
  pv_d0(o, vb0 + s_cur, pa0, pa1, pa2, pa3);
  asm volatile("s_waitcnt vmcnt(0)" ::: "memory");
#undef ROT
#undef TROW
#undef SLOAD
#undef SWRITE
#undef SWAIT
#undef RESC
}

__device__ __forceinline__ void row_recips(float l, float* li_l, int r32, int hi, float (&rli)[16]) {
  if (hi == 0) li_l[r32] = l;
  asm volatile("s_waitcnt lgkmcnt(0)" ::: "memory");
#pragma unroll
  for (int r = 0; r < 16; ++r) rli[r] = __builtin_amdgcn_rcpf(li_l[crow(r, hi)]);
  asm volatile("s_waitcnt lgkmcnt(0)" ::: "memory");
}
__device__ __forceinline__ unsigned short f2bf16(float f) { unsigned u = __builtin_bit_cast(unsigned, f); return (unsigned short)((u + 0x7fffu + ((u >> 16) & 1u)) >> 16); }
#undef SBAR
}
#define LAS __attribute__((address_space(3)))
typedef unsigned short bf16_t;
typedef unsigned v4u __attribute__((ext_vector_type(4)));
typedef unsigned v2u __attribute__((ext_vector_type(2)));
typedef float f32x4 __attribute__((ext_vector_type(4)));
constexpr int NWAVES = 8, NTHR = 512;
constexpr int DM = 2048, SEQ = 8192, CTX = 256, MTOT = SEQ + CTX, INW = 4608, DFF = 5632, UPW = 2 * DFF, NMODC = 6 * DM;
constexpr float EPS = 1e-6f;
constexpr size_t MiB = 1u << 20;
constexpr size_t WS_MOD = 0;
constexpr size_t MOD_BYTES = (size_t)2 * 2 * NMODC * 4;
constexpr size_t WS_BAR = 256 * 1024, CTL_ZERO_BYTES = 512 * 1024;
constexpr size_t WS_GTAB = 384 * 1024;
constexpr int MISC_OFF = 145408;
constexpr size_t WS_WIN = 1 * MiB, WS_WOUT = WS_WIN + 36 * MiB, WS_WUP = WS_WOUT + 16 * MiB, WS_WDN = WS_WUP + 88 * MiB;
constexpr size_t WS_H = WS_WDN + 44 * MiB, WS_XR = WS_H + 33 * MiB, WS_A2 = WS_XR + 66 * MiB, WS_U = WS_A2 + 91 * MiB, WS_END = WS_U + 182 * MiB;
constexpr size_t WS_P = WS_U, WS_Y = WS_U + 76 * MiB, WS_O1 = WS_U + 109 * MiB;
static_assert((size_t)(MTOT + 128) * INW * 2 <= 76 * MiB && (size_t)MTOT * DM * 2 <= 33 * MiB && WS_O1 + 256 * 262144 <= WS_END, "overlay map");
static_assert((size_t)MTOT * UPW * 2 <= 182 * MiB && (size_t)MTOT * DFF * 2 <= 91 * MiB && (size_t)MTOT * DM * 4 <= 66 * MiB, "ws map");
constexpr int LDS_BYTES = 147456;

struct Params {
    const float *x, *c, *ctx, *c_ctx, *w_ada, *b_ada, *norm1_g, *w_in, *w_out, *a_qk_g, *a_lambda, *a_subln_g, *b_qk_g, *c_qk_g, *c_sink, *d_qk_g, *d_rpb, *norm2_g, *w_up, *conv_w, *conv_b, *w_down;
    float* out; unsigned char* ws;
};

#define LDS_WAIT() asm volatile("s_waitcnt lgkmcnt(0)" ::: "memory")
__device__ __forceinline__ unsigned f2bf(float f) { unsigned u = __builtin_bit_cast(unsigned, f); return (u + 0x7fffu + ((u >> 16) & 1u)) >> 16; }
__device__ __forceinline__ unsigned pk2(float lo, float hi) { return f2bf(lo) | (f2bf(hi) << 16); }
__device__ __forceinline__ float bf_lo(unsigned w) { return __builtin_bit_cast(float, w << 16); }
__device__ __forceinline__ float bf_hi(unsigned w) { return __builtin_bit_cast(float, w & 0xffff0000u); }
__device__ __forceinline__ float wave_sum(float v) {
#pragma unroll
    for (int o = 1; o < 64; o <<= 1) v += __shfl_xor(v, o);
    return v;
}
__device__ __forceinline__ float silu_f(float v) { return v / (1.f + __expf(-v)); }

__device__ __forceinline__ void transpose_item(const float* __restrict__ W, int K, int N, bf16_t* __restrict__ WT, LAS float* scr, int item, int lane, bool remap_up = false, bool swap_mid = false) {
    const int nblk = N / 64, kb = item / nblk, nb = item % nblk, k0 = 64 * kb, n0 = 64 * nb;
    f32x4 v[16];
#pragma unroll
    for (int i = 0; i < 16; ++i) v[i] = *(const f32x4*)(W + (size_t)(k0 + 4 * i + (lane >> 4)) * N + n0 + (lane & 15) * 4);
#pragma unroll
    for (int i = 0; i < 16; ++i) { LAS float* s = scr + (4 * i + (lane >> 4)) * 65 + (lane & 15) * 4; s[0] = v[i].x; s[1] = v[i].y; s[2] = v[i].z; s[3] = v[i].w; }
    LDS_WAIT();
    const int c = lane & 7;
    const int d0 = !remap_up ? n0 : (n0 < DFF ? 256 * (n0 / 128) + (n0 % 128) : 256 * ((n0 - DFF) / 128) + 128 + ((n0 - DFF) % 128));
#pragma unroll
    for (int j = 0; j < 8; ++j) { const int n = (lane >> 3) + 8 * j; const LAS float* s = scr + (8 * c) * 65 + n;
        v4u o; o.x = pk2(s[0], s[65]); o.y = pk2(s[130], s[195]); o.z = pk2(s[260], s[325]); o.w = pk2(s[390], s[455]);
        const int nd = swap_mid ? ((((n >> 4) == 1) ? 32 : ((n >> 4) == 2) ? 16 : (n & 48)) + (n & 15)) : n;
        *(v4u*)(WT + (size_t)(d0 + nd) * K + k0 + 8 * c) = o; }
    LDS_WAIT();
}

#define PHASE_IDS() int tid_ = threadIdx.x; asm volatile("" : "+v"(tid_)); const int tid = tid_, lane = tid & 63, wave = __builtin_amdgcn_readfirstlane(tid >> 6); \
    const int gw = blockIdx.x * NWAVES + wave, NGW = gridDim.x * NWAVES; (void)lane; (void)gw; (void)NGW
__device__ __forceinline__ void adaln_gemv(const Params& p, int lo, int hi, int first_wg) {
    PHASE_IDS();
    if ((int)blockIdx.x < first_wg) return;
    const int wg = ((int)blockIdx.x - first_wg) * NWAVES + wave, nwg = ((int)gridDim.x - first_wg) * NWAVES;
    float* mod = (float*)(p.ws + WS_MOD);
    for (int it = lo + wg; it < hi; it += nwg) {
        const int i = it / 3072, r = it % 3072, kc = r / 48, cgp = r % 48, col = cgp * 256 + lane * 4;
        const float* W = p.w_ada + (size_t)i * DM * NMODC + (size_t)(kc * 32) * NMODC + col;
        f32x4 a0 = {0.f, 0.f, 0.f, 0.f}, a1 = {0.f, 0.f, 0.f, 0.f};
#pragma unroll 8
        for (int k = 0; k < 32; ++k) { const f32x4 w = *(const f32x4*)(W + (size_t)k * NMODC);
            const float s0 = silu_f(p.c[kc * 32 + k]), s1 = silu_f(p.c_ctx[kc * 32 + k]); a0 += w * s0; a1 += w * s1; }
        if (kc == 0) { const f32x4 b = *(const f32x4*)(p.b_ada + (size_t)i * NMODC + col); a0 += b; a1 += b; }
        float* m0 = mod + (size_t)(i * 2 + 0) * NMODC + col; float* m1 = mod + (size_t)(i * 2 + 1) * NMODC + col;
        atomicAdd(m0 + 0, a0.x); atomicAdd(m0 + 1, a0.y); atomicAdd(m0 + 2, a0.z); atomicAdd(m0 + 3, a0.w);
        atomicAdd(m1 + 0, a1.x); atomicAdd(m1 + 1, a1.y); atomicAdd(m1 + 2, a1.z); atomicAdd(m1 + 3, a1.w);
    }
}
__device__ __forceinline__ void prologue_phase(const Params& p, LAS unsigned char* lds) {
    PHASE_IDS();
    if (blockIdx.x == 0) { float* gt = (float*)(p.ws + WS_GTAB);
        for (int q = tid; q < 896; q += NTHR) gt[q] = q < 128 ? p.a_qk_g[q] : q < 384 ? p.b_qk_g[q - 128] : q < 640 ? p.c_qk_g[q - 384] : p.d_qk_g[q - 640]; }
}

constexpr int I_IN = (DM / 64) * (INW / 64), I_OUT = (DM / 64) * (DM / 64), I_UP = (DM / 64) * (UPW / 64), I_DN = (DFF / 64) * (DM / 64), I_L = I_IN + I_OUT + I_UP + I_DN;
__device__ __forceinline__ void convert_items(const Params& p, LAS unsigned char* lds, int lo, int hi, int first_wg) {
    PHASE_IDS();
    if ((int)blockIdx.x < first_wg) return;
    LAS float* scr = (LAS float*)(lds + wave * 16640);
    bf16_t* Win = (bf16_t*)(p.ws + WS_WIN); bf16_t* Wout = (bf16_t*)(p.ws + WS_WOUT); bf16_t* Wup = (bf16_t*)(p.ws + WS_WUP); bf16_t* Wdn = (bf16_t*)(p.ws + WS_WDN);
    const int wg = ((int)blockIdx.x - first_wg) * NWAVES + wave, nwg = ((int)gridDim.x - first_wg) * NWAVES;
    for (int it = lo + wg; it < hi; it += nwg) {
        const int i = it / I_L; int r = it % I_L;
        if (r < I_IN) { const int n0 = (r % (INW / 64)) * 64;
            const bool sw = (i == 0) ? (n0 >= 3072 && n0 < 4352) : (n0 < 1280);
            transpose_item(p.w_in + (size_t)i * DM * INW, DM, INW, Win + (size_t)i * INW * DM, scr, r, lane, false, sw); continue; } r -= I_IN;
        if (r < I_OUT) { transpose_item(p.w_out + (size_t)i * DM * DM, DM, DM, Wout + (size_t)i * DM * DM, scr, r, lane); continue; } r -= I_OUT;
        if (r < I_UP) { transpose_item(p.w_up + (size_t)i * DM * UPW, DM, UPW, Wup + (size_t)i * UPW * DM, scr, r, lane, true); continue; } r -= I_UP;
        transpose_item(p.w_down + (size_t)i * DFF * DM, DFF, DM, Wdn + (size_t)i * DM * DFF, scr, r, lane);
    }
}

__device__ __forceinline__ void norm_store(const f32x4 (&v)[8], float rstd, int gr, const float* __restrict__ g, const float* md, bf16_t* __restrict__ H, float* copy_ctx, int lane) {
#pragma unroll
    for (int j = 0; j < 8; ++j) { const int col = 4 * lane + 256 * j;
        if (copy_ctx && gr < CTX) *((f32x4*)(copy_ctx + (size_t)gr * DM) + lane + 64 * j) = v[j];
        const f32x4 g4 = *(const f32x4*)(g + col), sh = *(const f32x4*)(md + col), sc = *(const f32x4*)(md + DM + col);
        const f32x4 y = (v[j] * rstd) * g4, o = y * (sc + 1.f) + sh;
        v2u w; w.x = pk2(o.x, o.y); w.y = pk2(o.z, o.w);
        *(v2u*)(H + (size_t)gr * DM + col) = w; }
}
__device__ __forceinline__ void norm_phase(const float* src_ctx, const float* src_lat, const float* __restrict__ g, const float* mod_lat, const float* mod_ctx, int sidx,
                                           bf16_t* __restrict__ H, int row_lo, float* copy_ctx = nullptr) {
    PHASE_IDS();
    for (int gr0 = row_lo + gw; gr0 < MTOT; gr0 += 2 * NGW) {
        const int gr1 = gr0 + NGW; const bool has1 = gr1 < MTOT; const int grb = has1 ? gr1 : gr0;
        const float* xr0 = (gr0 < CTX ? src_ctx : src_lat) + (size_t)gr0 * DM; const float* xr1 = (grb < CTX ? src_ctx : src_lat) + (size_t)grb * DM;
        f32x4 v0[8], v1[8]; float ss0 = 0.f, ss1 = 0.f;
#pragma unroll
        for (int j = 0; j < 8; ++j) { v0[j] = *((const f32x4*)xr0 + lane + 64 * j); v1[j] = *((const f32x4*)xr1 + lane + 64 * j); }
#pragma unroll
        for (int j = 0; j < 8; ++j) { ss0 += (v0[j].x * v0[j].x + v0[j].y * v0[j].y) + (v0[j].z * v0[j].z + v0[j].w * v0[j].w); ss1 += (v1[j].x * v1[j].x + v1[j].y * v1[j].y) + (v1[j].z * v1[j].z + v1[j].w * v1[j].w); }
        const float rstd0 = rsqrtf(wave_sum(ss0) * (1.f / DM) + EPS), rstd1 = rsqrtf(wave_sum(ss1) * (1.f / DM) + EPS);
        norm_store(v0, rstd0, gr0, g, (gr0 < CTX ? mod_ctx : mod_lat) + (size_t)sidx * DM, H, copy_ctx, lane);
        if (has1) norm_store(v1, rstd1, gr1, g, (gr1 < CTX ? mod_ctx : mod_lat) + (size_t)sidx * DM, H, copy_ctx, lane);
    }
}

template <int LAYER>
__device__ __forceinline__ void qkrope_phase(const Params& p, bf16_t* P) {
    PHASE_IDS();
    for (int gr = gw; gr < MTOT + 128; gr += NGW) {
        if (gr >= MTOT) {
            for (int ch = lane; ch < INW / 8; ch += 64) *(v4u*)(P + (size_t)gr * INW + ch * 8) = (v4u){0u, 0u, 0u, 0u};
            continue;
        }
        const bool lat = gr >= CTX; const int tpos = gr - CTX;
#pragma unroll 1
        for (int it = 0; it < 7; ++it) {
            const int cgp = it * 64 + lane; const bool act = cgp < 416; const int ch = act ? cgp : 415;
            int col; bool w64; const float* g; bool rope;
            if (LAYER == 0) {
                col = ch < 256 ? 8 * ch : 3072 + 8 * (ch - 256); w64 = ch < 256; rope = lat;
                g = ch < 128 ? p.a_qk_g : ch < 256 ? p.a_qk_g + 64 : ch < 384 ? p.b_qk_g : p.b_qk_g + 128;
            } else {
                col = ch < 160 ? 8 * ch : 1536 + 8 * (ch - 160); w64 = false; rope = lat && ch < 160;
                g = ch < 128 ? p.c_qk_g : ch < 160 ? p.c_qk_g + 128 : ch < 288 ? p.d_qk_g : p.d_qk_g + 128;
            }
            bf16_t* ptr = P + (size_t)gr * INW + col;
            const v4u raw = *(const v4u*)ptr;
            float xv[8] = {bf_lo(raw.x), bf_hi(raw.x), bf_lo(raw.y), bf_hi(raw.y), bf_lo(raw.z), bf_hi(raw.z), bf_lo(raw.w), bf_hi(raw.w)};
            float ss = 0.f;
#pragma unroll
            for (int e = 0; e < 8; ++e) ss += xv[e] * xv[e];
            ss += __shfl_xor(ss, 1); ss += __shfl_xor(ss, 2); ss += __shfl_xor(ss, 4);
            const float ss8 = __shfl_xor(ss, 8);
            if (!w64) ss += ss8;
            const float rstd = rsqrtf(ss * (w64 ? 1.f / 64.f : 1.f / 128.f) + EPS);
            const int dbase = w64 ? (col & 63) : (col & 127);
            const f32x4 ga = *(const f32x4*)(g + dbase), gb = *(const f32x4*)(g + dbase + 4);
            const float gg[8] = {ga.x, ga.y, ga.z, ga.w, gb.x, gb.y, gb.z, gb.w};
#pragma unroll
            for (int e = 0; e < 8; ++e) xv[e] = xv[e] * rstd * gg[e];
            const int L = w64 ? (ch & 7) : (ch & 15);
            const int sub = w64 ? (L >> 2) : (L >> 3);
            const bool first = w64 ? ((L & 2) == 0) : ((L & 4) == 0);
            const int fi0 = w64 ? 8 * (L & 1) : 8 * (L & 3);
            const float fstep = w64 ? (-13.287712379549449f / 16.f) : (-13.287712379549449f / 32.f);
            const float pos = (float)(sub ? (tpos & 63) : (tpos >> 6));
            float ov[8];
#pragma unroll
            for (int e = 0; e < 8; ++e) {
                const float o2 = __shfl_xor(xv[e], 2), o4 = __shfl_xor(xv[e], 4);
                const float other = w64 ? o2 : o4;
                const float ang = pos * __builtin_amdgcn_exp2f((float)(fi0 + e) * fstep);
                const float cs = __cosf(ang), sn = __sinf(ang);
                const float rot = first ? xv[e] * cs - other * sn : xv[e] * cs + other * sn;
                ov[e] = rope ? rot : xv[e];
            }
            if (act) { v4u w; w.x = pk2(ov[0], ov[1]); w.y = pk2(ov[2], ov[3]); w.z = pk2(ov[4], ov[5]); w.w = pk2(ov[6], ov[7]); *(v4u*)ptr = w; }
        }
    }
}

__device__ __forceinline__ void conv_phase(const bf16_t* __restrict__ U, const float* __restrict__ cw, const float* __restrict__ cb, bf16_t* __restrict__ A2, int run_lo) {
    PHASE_IDS(); const long gtid = (long)blockIdx.x * NTHR + tid, NT_all = (long)gridDim.x * NTHR;
    constexpr int NCH = DFF / 8;
    for (long it = (long)run_lo * NCH + gtid; it < (long)(MTOT / 8) * NCH; it += NT_all) {
        const int run = (int)(it / NCH), ch = (int)(it % NCH), t0 = run * 8, c0 = ch * 8;
        const int lo = t0 < CTX ? 0 : CTX, hi = t0 < CTX ? CTX : MTOT;
        float wa[3][8], wg[3][8], ba[8], bg[8];
#pragma unroll
        for (int j = 0; j < 3; ++j)
#pragma unroll
            for (int e = 0; e < 8; e += 4) { const f32x4 a = *(const f32x4*)(cw + (size_t)j * UPW + c0 + e), g = *(const f32x4*)(cw + (size_t)j * UPW + DFF + c0 + e);
                wa[j][e] = a.x; wa[j][e + 1] = a.y; wa[j][e + 2] = a.z; wa[j][e + 3] = a.w; wg[j][e] = g.x; wg[j][e + 1] = g.y; wg[j][e + 2] = g.z; wg[j][e + 3] = g.w; }
#pragma unroll
        for (int e = 0; e < 8; e += 4) { const f32x4 a = *(const f32x4*)(cb + c0 + e), g = *(const f32x4*)(cb + DFF + c0 + e);
            ba[e] = a.x; ba[e + 1] = a.y; ba[e + 2] = a.z; ba[e + 3] = a.w; bg[e] = g.x; bg[e + 1] = g.y; bg[e + 2] = g.z; bg[e + 3] = g.w; }
        const v4u z = {0u, 0u, 0u, 0u};
        v4u pa = (t0 - 1 >= lo) ? *(const v4u*)(U + (size_t)(t0 - 1) * UPW + c0) : z, pg = (t0 - 1 >= lo) ? *(const v4u*)(U + (size_t)(t0 - 1) * UPW + DFF + c0) : z;
        v4u ca = *(const v4u*)(U + (size_t)t0 * UPW + c0), cg_ = *(const v4u*)(U + (size_t)t0 * UPW + DFF + c0);
#pragma unroll
        for (int r = 0; r < 8; ++r) {
            const int t = t0 + r;
            const v4u na = (t + 1 < hi) ? *(const v4u*)(U + (size_t)(t + 1) * UPW + c0) : z, ng = (t + 1 < hi) ? *(const v4u*)(U + (size_t)(t + 1) * UPW + DFF + c0) : z;
            float oa[8], og[8];
#define CONV2(k, PW, CW_, NW_, OUT, WT, BS) OUT[2 * k] = BS[2 * k] + bf_lo(PW) * WT[0][2 * k] + bf_lo(CW_) * WT[1][2 * k] + bf_lo(NW_) * WT[2][2 * k]; \
                                              OUT[2 * k + 1] = BS[2 * k + 1] + bf_hi(PW) * WT[0][2 * k + 1] + bf_hi(CW_) * WT[1][2 * k + 1] + bf_hi(NW_) * WT[2][2 * k + 1];
            CONV2(0, pa.x, ca.x, na.x, oa, wa, ba) CONV2(1, pa.y, ca.y, na.y, oa, wa, ba) CONV2(2, pa.z, ca.z, na.z, oa, wa, ba) CONV2(3, pa.w, ca.w, na.w, oa, wa, ba)
            CONV2(0, pg.x, cg_.x, ng.x, og, wg, bg) CONV2(1, pg.y, cg_.y, ng.y, og, wg, bg) CONV2(2, pg.z, cg_.z, ng.z, og, wg, bg) CONV2(3, pg.w, cg_.w, ng.w, og, wg, bg)
#undef CONV2
            float y[8];
#pragma unroll
            for (int e = 0; e < 8; ++e) y[e] = silu_f(og[e]) * oa[e];
            v4u w; w.x = pk2(y[0], y[1]); w.y = pk2(y[2], y[3]); w.z = pk2(y[4], y[5]); w.w = pk2(y[6], y[7]);
            *(v4u*)(A2 + (size_t)t * DFF + c0) = w;
            pa = ca; pg = cg_; ca = na; cg_ = ng;
        }
    }
}

__device__ __forceinline__ void conv_fix_phase(const bf16_t* __restrict__ U, const float* __restrict__ cw, const float* __restrict__ cb, bf16_t* __restrict__ A2, int tile_lo) {
    PHASE_IDS(); const long gtid = (long)blockIdx.x * NTHR + tid, NT_all = (long)gridDim.x * NTHR;
    constexpr int NCH = DFF / 8;
    for (long it = (long)tile_lo * 8 * NCH + gtid; it < (long)(MTOT / 256) * 8 * NCH; it += NT_all) {
        const int rk = (int)(it / NCH), ch = (int)(it % NCH), c0 = ch * 8, tile = rk >> 3, k = rk & 7;
        const int t = tile * 256 + ((k + 1) >> 1) * 64 - (k & 1);
        const int lo = t < CTX ? 0 : CTX, hi = t < CTX ? CTX : MTOT;
        const v4u z = {0u, 0u, 0u, 0u};
        const v4u pa = (t - 1 >= lo) ? *(const v4u*)(U + (size_t)(t - 1) * UPW + c0) : z, pg = (t - 1 >= lo) ? *(const v4u*)(U + (size_t)(t - 1) * UPW + DFF + c0) : z;
        const v4u ca = *(const v4u*)(U + (size_t)t * UPW + c0), cg_ = *(const v4u*)(U + (size_t)t * UPW + DFF + c0);
        const v4u na = (t + 1 < hi) ? *(const v4u*)(U + (size_t)(t + 1) * UPW + c0) : z, ng = (t + 1 < hi) ? *(const v4u*)(U + (size_t)(t + 1) * UPW + DFF + c0) : z;
        const unsigned pav[4] = {pa.x, pa.y, pa.z, pa.w}, pgv[4] = {pg.x, pg.y, pg.z, pg.w}, cav[4] = {ca.x, ca.y, ca.z, ca.w}, cgv[4] = {cg_.x, cg_.y, cg_.z, cg_.w}, nav[4] = {na.x, na.y, na.z, na.w}, ngv[4] = {ng.x, ng.y, ng.z, ng.w};
        unsigned ow[4];
#pragma unroll
        for (int q = 0; q < 4; ++q) {
            float y[2];
#pragma unroll
            for (int e = 0; e < 2; ++e) { const int c = c0 + 2 * q + e;
                const float xa0 = e ? bf_hi(pav[q]) : bf_lo(pav[q]), xa1 = e ? bf_hi(cav[q]) : bf_lo(cav[q]), xa2 = e ? bf_hi(nav[q]) : bf_lo(nav[q]);
                const float xg0 = e ? bf_hi(pgv[q]) : bf_lo(pgv[q]), xg1 = e ? bf_hi(cgv[q]) : bf_lo(cgv[q]), xg2 = e ? bf_hi(ngv[q]) : bf_lo(ngv[q]);
                const float oa = cb[c] + xa0 * cw[c] + xa1 * cw[UPW + c] + xa2 * cw[2 * UPW + c];
                const float og = cb[DFF + c] + xg0 * cw[DFF + c] + xg1 * cw[UPW + DFF + c] + xg2 * cw[2 * UPW + DFF + c];
                y[e] = silu_f(og) * oa; }
            ow[q] = pk2(y[0], y[1]);
        }
        *(v4u*)(A2 + (size_t)t * DFF + c0) = (v4u){ow[0], ow[1], ow[2], ow[3]};
    }
}

__device__ __forceinline__ void zero_pad_rows(bf16_t* P) {
    PHASE_IDS();
    unsigned zz = 0u; asm volatile("" : "+v"(zz));
    for (int q = (int)blockIdx.x * NTHR + tid; q < 128 * INW / 8; q += (int)gridDim.x * NTHR) *(v4u*)(P + (size_t)MTOT * INW + (size_t)q * 8) = (v4u){zz, zz, zz, zz};
}

__device__ __forceinline__ void attn_store(att::f32x16 (&o)[4], float l, char* lds, bf16_t* Yb  ) {
    int tid_ = threadIdx.x; asm volatile("" : "+v"(tid_));
    const int tid = tid_, wid = tid >> 6, lane = tid & 63, r32 = lane & 31, hi = lane >> 5;
    float* li_l = (float*)(lds + att::OFF_WS) + wid * 64;
    float rli[16]; att::row_recips(l, li_l, r32, hi, rli);
#pragma unroll
    for (int r = 0; r < 16; ++r) { const int orow = wid * 32 + att::crow(r, hi);
#pragma unroll
        for (int d0 = 0; d0 < 4; ++d0) Yb[(size_t)orow * att::LDY + d0 * 32 + r32] = (bf16_t)f2bf(o[d0][r] * rli[r]); }
}

__device__ __forceinline__ void attn_store_f32(att::f32x16 (&o)[4], float l, char* lds, float* dst) {
    int tid_ = threadIdx.x; asm volatile("" : "+v"(tid_));
    const int tid = tid_, wid = tid >> 6, lane = tid & 63, r32 = lane & 31, hi = lane >> 5;
    float* li_l = (float*)(lds + att::OFF_WS) + wid * 64;
    float rli[16]; att::row_recips(l, li_l, r32, hi, rli);
#pragma unroll
    for (int r = 0; r < 16; ++r) { const int orow = wid * 32 + att::crow(r, hi);
#pragma unroll
        for (int d0 = 0; d0 < 4; ++d0) dst[orow * 128 + d0 * 32 + r32] = o[d0][r] * rli[r]; }
}

__device__ __forceinline__ void attn_layer0(const Params& p, char* lds, int vcu, int G) {
    const att::bf16* P = (const att::bf16*)(p.ws + WS_P); bf16_t* Y = (bf16_t*)(p.ws + WS_Y);
    int tid_ = threadIdx.x; asm volatile("" : "+v"(tid_));
    const int tid = tid_, wid = tid >> 6, lane = tid & 63;
    const att::MaskCtx mc{0, 0, 0, nullptr};
    float* o12 = (float*)(p.ws + WS_O1) + (size_t)blockIdx.x * 65536;
#pragma unroll 1
    for (int u = vcu; u < 264; u += G) {
        const bool lat = u < 256; const int h = lat ? u >> 5 : u - 256, row0 = lat ? CTX + (u & 31) * 256 : 0, NT = lat ? 132 : 4;
#pragma unroll 1
        for (int m = 0; m < 2; ++m) {
            att::f32x16 o[4]; float m_reg, l_reg;
            att::attn_core<64, 0>(P + (size_t)row0 * INW + h * 128 + m * 64, P + 1024 + h * 128 + m * 64, P + 2048 + h * 128, NT, 0, mc, lds, o, m_reg, l_reg);
            attn_store_f32(o, l_reg, lds, o12 + m * 32768);
        }
        asm volatile("s_waitcnt vmcnt(0)" ::: "memory");
        float s01 = 0.f, s23 = 0.f;
        for (int e = 0; e < 64; ++e) { s01 += p.a_lambda[e] * p.a_lambda[64 + e]; s23 += p.a_lambda[128 + e] * p.a_lambda[192 + e]; }
        const float lam = __expf(s01) - __expf(s23) + 0.2f;
        const float g0 = p.a_subln_g[2 * lane], g1 = p.a_subln_g[2 * lane + 1];
#pragma unroll 4
        for (int rr = 0; rr < 32; ++rr) {
            const int row = wid * 32 + rr;
            const float2 a = *(const float2*)(o12 + row * 128 + 2 * lane), b = *(const float2*)(o12 + 32768 + row * 128 + 2 * lane);
            const float d0 = a.x - lam * b.x, d1 = a.y - lam * b.y;
            const float sc = rsqrtf(wave_sum(d0 * d0 + d1 * d1) * (1.f / 128.f) + EPS) * 0.8f;
            *(unsigned*)(Y + (size_t)(row0 + row) * DM + h * 128 + 2 * lane) = pk2(d0 * sc * g0, d1 * sc * g1);
        }
    }
#pragma unroll 1
    for (int u = vcu; u < 264; u += G) {
        const bool lat = u < 256; const int h = lat ? u >> 5 : u - 256, row0 = lat ? CTX + (u & 31) * 256 : 0, NT = lat ? 132 : 4;
        att::f32x16 o[4]; float m_reg, l_reg;
        att::attn_core<128, 0>(P + (size_t)row0 * INW + 3072 + h * 128, P + 4096 + (h >> 2) * 128, P + 4352 + (h >> 2) * 128, NT, 0, mc, lds, o, m_reg, l_reg);
        attn_store(o, l_reg, lds, Y + (size_t)row0 * DM + 1024 + h * 128);
    }
}

__device__ __forceinline__ void attn_layer1(const Params& p, char* lds, int vcu, int G) {
    const att::bf16* P = (const att::bf16*)(p.ws + WS_P); bf16_t* Y = (bf16_t*)(p.ws + WS_Y);
    int tid_ = threadIdx.x; asm volatile("" : "+v"(tid_));
    const int tid = tid_, wid = tid >> 6, lane = tid & 63, r32 = lane & 31;
#pragma unroll 1
    for (int u = vcu; u < 256; u += G) {
        const int h = u >> 5, qb = u & 31, q0 = qb * 256, row0 = CTX + q0;
        const att::MaskCtx mc{q0 + wid * 32 + r32, q0 - 128, 0, nullptr};
        att::f32x16 o[4]; float m_reg, l_reg;
        att::attn_core<128, 1>(P + (size_t)row0 * INW + h * 128, P + 1024 + (h >> 2) * 128, P + 1280 + (h >> 2) * 128, 12, CTX + q0 - 128, mc, lds, o, m_reg, l_reg);
        constexpr float C = 0.088388347648318440f * 1.4426950408889634f;
        const float l = l_reg + __builtin_amdgcn_exp2f(p.c_sink[h] * 1.4426950408889634f - m_reg * C);
        attn_store(o, l, lds, Y + (size_t)row0 * DM + h * 128);
    }
    float* tab = (float*)(lds + att::OFF_TAB);
#pragma unroll 1
    for (int u = vcu; u < 256; u += G) {
        const int h = u >> 5, qb = u & 31, q0 = qb * 256, row0 = CTX + q0, r0 = qb * 4;
        const int base = min(max(r0 - 4, 0), 116);
        __syncthreads();
        if (tid < 465) tab[tid] = p.d_rpb[h * 465 + tid] * 11.313708498984761f;
        const att::MaskCtx mc{r0 + (wid >> 1), (wid & 1) * 32 + r32, base, tab};
        att::f32x16 o[4]; float m_reg, l_reg;
        att::attn_core<128, 2>(P + (size_t)row0 * INW + 1536 + h * 128, P + 2560 + h * 128, P + 3584 + h * 128, 16, CTX + base * 64, mc, lds, o, m_reg, l_reg);
        attn_store(o, l_reg, lds, Y + (size_t)row0 * DM + 1024 + h * 128);
    }
}

#define GAS __attribute__((address_space(1)))
typedef GAS unsigned gu32;
typedef GAS unsigned long long gu64;
#define RLX_AGENT __ATOMIC_RELAXED, __HIP_MEMORY_SCOPE_AGENT
#define XB_TMO      128
#define XB_XCNT(j)  (256  + 64 * (j))
#define XB_XSUB(j)  (1280 + 64 * (j))
#define XB_XGEN(j)  (2304 + 64 * (j))
#define XB_TOP      3328
#define XB_TOPGEN   3392
#define XCD_BAR_WORDS 3456
#define XB_SPIN_CAP (1u << 18)

__device__ __forceinline__ unsigned xb_ld(unsigned* p)              { return __hip_atomic_load(p, __ATOMIC_RELAXED, __HIP_MEMORY_SCOPE_AGENT); }
__device__ __forceinline__ unsigned xb_add(unsigned* p, unsigned v) { return __hip_atomic_fetch_add(p, v, __ATOMIC_RELAXED, __HIP_MEMORY_SCOPE_AGENT); }
__device__ __forceinline__ unsigned xb_xcc_id() { return (unsigned)__builtin_amdgcn_s_getreg((3 << 11) | 20) & 0xFu; }
#define XB_SPIN(cond, bar) do { unsigned _sp = 0; while (cond) { __builtin_amdgcn_s_sleep(1); \
    if ((++_sp & 255u) == 0u) { if (xb_ld(&(bar)[XB_TMO])) break; if (_sp > XB_SPIN_CAP) { atomicAdd(&(bar)[XB_TMO], 1u); break; } } } } while (0)

struct XcdBarrier {
    unsigned* bar; unsigned x;
    volatile LAS unsigned* st;
};

__device__ __forceinline__ XcdBarrier xcd_barrier_post(unsigned* bar, volatile LAS unsigned* st) {
    XcdBarrier b; b.bar = bar; b.x = xb_xcc_id(); b.st = st;
    if (threadIdx.x == 0) (void)xb_add(&bar[XB_XCNT(b.x)], 1u);
    return b;
}
__device__ __forceinline__ void xcd_barrier_complete(unsigned* bar, unsigned x, unsigned& nloc, unsigned& nx) {
    const unsigned G = gridDim.x * gridDim.y * gridDim.z;
    unsigned sum, cnt, mine, sp = 0u;
    for (;;) {
        sum = 0u; cnt = 0u; mine = 0u;
#pragma unroll
        for (unsigned j = 0; j < 16; ++j) { const unsigned c = xb_ld(&bar[XB_XCNT(j)]); sum += c; cnt += (c > 0u) ? 1u : 0u; mine = (j == x) ? c : mine; }
        if (sum == G) break;
        __builtin_amdgcn_s_sleep(1);
        if ((++sp & 255u) == 0u) { if (xb_ld(&bar[XB_TMO])) break; if (sp > XB_SPIN_CAP) { atomicAdd(&bar[XB_TMO], 1u); break; } }
    }
    nloc = mine > 0u ? mine : 1u; nx = cnt > 0u ? cnt : 1u;
}

__device__ __forceinline__ void xcd_barrier(const XcdBarrier& b) {
    asm volatile("s_waitcnt vmcnt(0)" ::: "memory");
    __syncthreads();
    if (threadIdx.x == 0) {
        unsigned* bar = b.bar; asm volatile("" : "+s"(bar));
        unsigned bx_ = b.x; asm volatile("" : "+s"(bx_));
        __builtin_amdgcn_s_waitcnt(0);
        unsigned nloc = b.st[0], nx = b.st[1];
        if (nloc == 0u) { xcd_barrier_complete(bar, bx_, nloc, nx); b.st[0] = nloc; b.st[1] = nx; }
        const unsigned old = xb_add(&bar[XB_XSUB(bx_)], 1u);
        const unsigned gen = old / nloc;
        if (old + 1u == (gen + 1u) * nloc) {
            __builtin_amdgcn_fence(__ATOMIC_RELEASE, "agent");
            asm volatile("s_waitcnt vmcnt(0)" ::: "memory");
            const unsigned og = xb_add(&bar[XB_TOP], 1u);
            const unsigned tg = og / nx;
            if (og + 1u == (tg + 1u) * nx) xb_add(&bar[XB_TOPGEN], 1u);
            else XB_SPIN(xb_ld(&bar[XB_TOPGEN]) == tg, bar);
            __builtin_amdgcn_fence(__ATOMIC_ACQUIRE, "agent");
            xb_add(&bar[XB_XGEN(bx_)], 1u);
            asm volatile("s_waitcnt vmcnt(0)" ::: "memory");
        } else {
            XB_SPIN(xb_ld(&bar[XB_XGEN(bx_)]) == gen, bar);
            __builtin_amdgcn_fence(__ATOMIC_ACQUIRE, "agent");
            asm volatile("s_waitcnt vmcnt(0)" ::: "memory");
        }
    }
    __syncthreads();
}

__global__ void __launch_bounds__(NTHR, 2) mega_fwd(Params p) {
    extern __shared__ __attribute__((aligned(16))) unsigned char lds_raw[];
    cg::grid_group grid = cg::this_grid();
    LAS unsigned char* lds = (LAS unsigned char*)lds_raw;
    const int G = gridDim.x, bx = blockIdx.x, vcu = (G % 8 == 0) ? (bx % 8) * (G / 8) + bx / 8 : bx;
    unsigned char* ws = p.ws;
    float* mod = (float*)(ws + WS_MOD);
    bf16_t* H = (bf16_t*)(ws + WS_H); float* XR = (float*)(ws + WS_XR); bf16_t* A2 = (bf16_t*)(ws + WS_A2); bf16_t* U = (bf16_t*)(ws + WS_U);
    bf16_t* P = (bf16_t*)(ws + WS_P); bf16_t* Y = (bf16_t*)(ws + WS_Y);

    volatile LAS unsigned* misc = (volatile LAS unsigned*)(lds + MISC_OFF);
    if (threadIdx.x < 2) misc[threadIdx.x] = 0u;
    __syncthreads();
    const XcdBarrier bar = xcd_barrier_post((unsigned*)(ws + WS_BAR), misc);
#define GRID_SYNC() xcd_barrier(bar)
    prologue_phase(p, lds);
    adaln_gemv(p, 0, 3072, 0);
    convert_items(p, lds, 0, I_IN, 0);
    if (p.ws == nullptr) grid.sync();
    GRID_SYNC();
#pragma unroll 1
    for (int i = 0; i < 2; ++i) {
        const float* mod_lat = mod + (size_t)(i * 2 + 0) * NMODC; const float* mod_ctx = mod + (size_t)(i * 2 + 1) * NMODC;
        const bf16_t* Win = (const bf16_t*)(ws + WS_WIN) + (size_t)i * INW * DM; const bf16_t* Wout = (const bf16_t*)(ws + WS_WOUT) + (size_t)i * DM * DM;
        const bf16_t* Wup = (const bf16_t*)(ws + WS_WUP) + (size_t)i * UPW * DM; const bf16_t* Wdn = (const bf16_t*)(ws + WS_WDN) + (size_t)i * DM * DFF;
        if (i == 0) norm_phase(p.ctx, p.x - (size_t)CTX * DM, p.norm1_g, mod_lat, mod_ctx, 0, H, 0, XR);
        else      { norm_phase(XR, XR, p.norm1_g + DM, mod_lat, mod_ctx, 0, H, 0); zero_pad_rows(P); }
        GRID_SYNC();
        { pg8::Gemm g{H, Win, MTOT, INW, DM, DM}; pg8::StaticOrder S; S.init(MTOT, INW, G, bx);
          PG8_LAS float* part = (PG8_LAS float*)(lds + 131072);
          if (i == 0) { const pg8::EpiQKV<0> E{P, (const float*)(ws + WS_GTAB), part}; pg8::gemm_phase<pg8::EpiQKV<0>, pg8::StaticOrder, true, true>(lds, g, S, E); }
          else        { const pg8::EpiQKV<1> E{P, (const float*)(ws + WS_GTAB) + 384, part}; pg8::gemm_phase<pg8::EpiQKV<1>, pg8::StaticOrder, true, true>(lds, g, S, E); } }
        if (i == 0) convert_items(p, lds, I_IN, I_IN + I_OUT + I_UP, ((MTOT / 256) * (INW / 256)) % G);
        else        convert_items(p, lds, I_L + I_IN, 2 * I_L, ((MTOT / 256) * (INW / 256)) % G);
        GRID_SYNC();
        if (i == 0) attn_layer0(p, (char*)lds_raw, vcu, G); else attn_layer1(p, (char*)lds_raw, vcu, G);
        GRID_SYNC();
        { const pg8::Gemm g{Y + (size_t)CTX * DM, Wout, SEQ, DM, DM, DM};
          pg8::StaticOrder S; S.init(SEQ, DM, G, bx);
          const pg8::EpiGateRes E{XR, (i == 0) ? p.x - (size_t)CTX * DM : XR, XR, mod_ctx + 2 * DM, mod_lat + 2 * DM, CTX};
          pg8::gemm_phase<pg8::EpiGateRes, pg8::StaticOrder, true, true>(lds, g, S, E); }
        if (i == 0) { const pg8::Gemm g{Y, Wout, CTX, DM, 256, DM};
          const pg8::SplitKOrder S{DM / 256, (DM / 256) * (DM / 256), 256, G, bx};
          const pg8::EpiGateAtomic E{XR, mod_ctx + 2 * DM};
          pg8::gemm_phase<pg8::EpiGateAtomic, pg8::SplitKOrder, false, true>(lds, g, S, E); }
        GRID_SYNC();
        norm_phase(XR, XR, p.norm2_g + (size_t)i * DM, mod_lat, mod_ctx, 3, H, i == 0 ? 0 : CTX);
        GRID_SYNC();
        { const pg8::Gemm g = (i == 0) ? pg8::Gemm{H, Wup, MTOT, UPW, DM, DM} : pg8::Gemm{H + (size_t)CTX * DM, Wup, SEQ, UPW, DM, DM};
          pg8::StaticOrder S; S.init(g.M, UPW, G, bx);
          const pg8::EpiConvGate E{A2, U, p.conv_w + (size_t)i * 3 * UPW, p.conv_b + (size_t)i * UPW, (i == 0) ? 0 : CTX};
          pg8::gemm_phase<pg8::EpiConvGate, pg8::StaticOrder, true, true>(lds, g, S, E); }
        if (i == 0) convert_items(p, lds, I_IN + I_OUT + I_UP, I_L + I_IN, ((MTOT / 256) * (UPW / 256)) % G);
        GRID_SYNC();
        conv_fix_phase(U, p.conv_w + (size_t)i * 3 * UPW, p.conv_b + (size_t)i * UPW, A2, i == 0 ? 0 : 1);
        GRID_SYNC();
        { const pg8::Gemm g{A2 + (size_t)CTX * DFF, Wdn, SEQ, DM, DFF, DFF};
          pg8::StaticOrder S; S.init(SEQ, DM, G, bx);
          const pg8::EpiGateRes E{XR, XR, (i == 0) ? XR : p.out - (size_t)CTX * DM, mod_ctx + 5 * DM, mod_lat + 5 * DM, CTX};
          pg8::gemm_phase<pg8::EpiGateRes, pg8::StaticOrder, true, true>(lds, g, S, E); }
        if (i == 0) { const pg8::Gemm g{A2, Wdn, CTX, DM, 512, DFF};
          const pg8::SplitKOrder S{DM / 256, (DM / 256) * (DFF / 512), 512, G, bx};
          const pg8::EpiGateAtomic E{XR, mod_ctx + 5 * DM};
          pg8::gemm_phase<pg8::EpiGateAtomic, pg8::SplitKOrder, false, true>(lds, g, S, E); }
        if (i == 0) { adaln_gemv(p, 3072, 6144, ((DM / 256) * (DFF / 512)) % G); GRID_SYNC(); }
    }
}

extern "C" void kernel_launch(void* const* d_in, const int* in_sizes, int n_in, void* d_out, int out_size, void* d_ws, size_t ws_size, hipStream_t stream) {
    static int grid = 0;
    if (grid == 0) {
        if (n_in != 22 || in_sizes[0] != SEQ * DM || out_size != SEQ * DM || ws_size < WS_END) {
            fprintf(stderr, "kernel_launch: unexpected shapes (n_in %d, in0 %d, out %d, ws %zu < %zu); nothing launched\n", n_in, n_in > 0 ? in_sizes[0] : -1, out_size, ws_size, (size_t)WS_END);
            grid = -1; return; }
        int dev = 0, cus = 0, per_cu = 0;
        (void)hipGetDevice(&dev); (void)hipDeviceGetAttribute(&cus, hipDeviceAttributeMultiprocessorCount, dev);
        if (hipFuncSetAttribute((const void*)mega_fwd, hipFuncAttributeMaxDynamicSharedMemorySize, LDS_BYTES) != hipSuccess) { fprintf(stderr, "kernel_launch: hipFuncSetAttribute failed\n"); grid = -1; return; }
        if (hipOccupancyMaxActiveBlocksPerMultiprocessor(&per_cu, (const void*)mega_fwd, NTHR, LDS_BYTES) != hipSuccess || per_cu < 1) { (void)hipGetLastError(); per_cu = 1; }
        grid = cus * (per_cu > 1 ? 1 : per_cu);
        if (grid <= 0) grid = 256;
    }
    if (grid < 0) return;
    (void)hipMemsetAsync((char*)d_ws + WS_MOD, 0, CTL_ZERO_BYTES, stream);
    Params p{};
    const float** pp = (const float**)&p;
    for (int i = 0; i < 22; ++i) pp[i] = (const float*)d_in[i];
    p.out = (float*)d_out; p.ws = (unsigned char*)d_ws;
    void* args[] = {&p};
    hipError_t e = hipLaunchCooperativeKernel((const void*)mega_fwd, dim3(grid), dim3(NTHR), args, LDS_BYTES, stream);
    if (e != hipSuccess) fprintf(stderr, "cooperative launch failed: %s (grid %d)\n", hipGetErrorString(e), grid);
}
```

```cpp
#include <hip/hip_runtime.h>
#include <hip/hip_cooperative_groups.h>
#include <hip/hip_bf16.h>
#include <cstdio>
#include <cstdint>
#include <cmath>
namespace cg = cooperative_groups;
namespace pg8 {
#define PG8_LAS __attribute__((address_space(3)))
typedef unsigned short bf16_t;
typedef short bf16x8 __attribute__((ext_vector_type(8)));
typedef float f32x4 __attribute__((ext_vector_type(4)));
typedef unsigned u32x4 __attribute__((ext_vector_type(4)));
constexpr int BM = 256, BK = 64, HALF = 128, HTB = HALF * BK * 2  , STAGE_BYTES = 8 * HTB, NXCD = 8, WGM = 8;

__host__ __device__ __forceinline__ int lds_byte(int r, int c) { const int st = (r >> 4) * 2 + (c >> 5), rr = r & 15, cc = c & 31, ob = rr * 64 + cc * 2; return st * 1024 + (ob ^ (((ob >> 9) & 1) << 5)); }
__host__ __device__ __forceinline__ void stage_rc(int b, int& R, int& C) { const int st = b / 1024, sb = b % 1024, swz = sb ^ (((sb >> 9) & 1) << 5); R = (st >> 1) * 16 + swz / 64; C = (st & 1) * 32 + (swz % 64) / 2; }
__host__ __device__ __forceinline__ int perm32(int rho) { const int n = rho >> 4, i = rho & 15; return 8 * (i >> 2) + 4 * n + (i & 3); }

struct Unit { int pm, pn, k0; };
struct Gemm { const bf16_t* A; const bf16_t* Bt; int M, N, K, ld; };

struct StaticOrder {
    int nM, nN, nwg, G, c;
    __host__ __device__ void init(int M, int N, int G_, int c_) { nM = M / BM; nN = N / BM; nwg = nM * nN; G = G_; c = c_; }
    __host__ __device__ bool next(int i, Unit& u) const {
        const long L = (long)i * G + c; if (L >= nwg) return false;
        int wgid = (int)L; { const int q = nwg / NXCD, r = nwg % NXCD, xcd = wgid % NXCD, off = wgid / NXCD; wgid = (xcd < r ? xcd * (q + 1) : r * (q + 1) + (xcd - r) * q) + off; }
        const int nig = WGM * nN, gid = wgid / nig, fm = gid * WGM, gsz = (nM - fm) < WGM ? (nM - fm) : WGM;
        u.pm = fm + ((wgid % nig) % gsz); u.pn = (wgid % nig) / gsz; u.k0 = 0; return true;
    }
    __device__ __forceinline__ void a_ready(const Unit&) const {}
    __device__ __forceinline__ void done(const Unit&) const {}
};

__device__ __forceinline__ unsigned cvt_pk_bf16(float lo, float hi) { unsigned r; asm volatile("v_cvt_pk_bf16_f32 %0, %1, %2" : "=v"(r) : "v"(lo), "v"(hi)); return r; }
typedef float f32x2 __attribute__((ext_vector_type(2)));
__device__ __forceinline__ f32x2 gelu_pk(f32x2 v) {
    const f32x2 av = __builtin_elementwise_abs(v), d = av * 0.2316418882f + 1.0f;
    f32x2 t; t.x = __builtin_amdgcn_rcpf(d.x); t.y = __builtin_amdgcn_rcpf(d.y);
    f32x2 q = t * 0.5307027145f + (-0.7265760135f); q = q * t + 0.7107068705f; q = q * t + (-0.142248368f); q = q * t + 0.127414796f; q = q * t;
    const f32x2 s = (v * v) * (-0.72134752044f);
    f32x2 e; e.x = __builtin_amdgcn_exp2f(s.x); e.y = __builtin_amdgcn_exp2f(s.y);
    const f32x2 m = v * (q * e), r = v - m;
    f32x2 o; o.x = v.x < 0.f ? m.x : r.x; o.y = v.y < 0.f ? m.y : r.y; return o;
}

template <int ACT  > struct EpiBf16 {
    static constexpr bool PERM = true, AFTER_DRAIN = false; static_assert(ACT == 0 || ACT == 1, "EpiBf16: ACT is 0 (none) or 1 (gelu_pk)");
    bf16_t* O; int ldc; const float* bias; int split_cols; size_t split_stride; float scale0;
    __device__ __forceinline__ void operator()(const f32x4 (&acc)[2][2][4][2], const Unit& u, int wr, int wc, int fr, int fq) const {
        const int row0 = u.pm * BM + wr * 64 + fr; int colt = u.pn * BM; bf16_t* base = O;
        float sc = 1.f; if (split_cols) { const int t = colt / split_cols; base += (size_t)t * split_stride; colt -= t * split_cols; if (t == 0) sc = scale0; }
        const int col0 = colt + wc * 32 + 8 * fq, bcol0 = u.pn * BM + wc * 32 + 8 * fq;
        f32x4 bv[2][2];
#pragma unroll
        for (int bj = 0; bj < 2; ++bj)
#pragma unroll
            for (int n = 0; n < 2; ++n) bv[bj][n] = bias ? *(const f32x4*)(bias + bcol0 + bj * HALF + 4 * n) : (f32x4){0.f, 0.f, 0.f, 0.f};
#pragma unroll
        for (int ai = 0; ai < 2; ++ai)
#pragma unroll
            for (int m = 0; m < 4; ++m) { bf16_t* rowp = base + (size_t)(row0 + ai * HALF + m * 16) * ldc + col0;
#pragma unroll
                for (int bj = 0; bj < 2; ++bj) { f32x4 v0 = acc[ai][bj][m][0] + bv[bj][0], v1 = acc[ai][bj][m][1] + bv[bj][1];
                    if (ACT == 1) { f32x2 a = gelu_pk((f32x2){v0[0], v0[1]}), b = gelu_pk((f32x2){v0[2], v0[3]}), c = gelu_pk((f32x2){v1[0], v1[1]}), d = gelu_pk((f32x2){v1[2], v1[3]});
                        v0 = (f32x4){a.x, a.y, b.x, b.y}; v1 = (f32x4){c.x, c.y, d.x, d.y}; }
                    v0 = v0 * sc; v1 = v1 * sc; u32x4 w; w.x = cvt_pk_bf16(v0[0], v0[1]); w.y = cvt_pk_bf16(v0[2], v0[3]); w.z = cvt_pk_bf16(v1[0], v1[1]); w.w = cvt_pk_bf16(v1[2], v1[3]);
                    *(u32x4*)(rowp + bj * HALF) = w; } }
    }
};
typedef unsigned u32x2_t __attribute__((ext_vector_type(2)));
struct EpiGateRes {
    static constexpr bool PERM = false, AFTER_DRAIN = false;
    const float* base_ctx; const float* base_lat; float* out; const float* gate_ctx; const float* gate_lat; int row_off;
    __device__ __forceinline__ void operator()(const f32x4 (&acc)[2][2][4][2], const Unit& u, int wr, int wc, int fr, int fq) const {
        const int grow0 = row_off + u.pm * BM; const bool isctx = grow0 < 256;
        const float* base = isctx ? base_ctx : base_lat; const float* gate = isctx ? gate_ctx : gate_lat;
        const int col0 = u.pn * BM + wc * 32 + 4 * fq;
        f32x4 gv[2][2];
#pragma unroll
        for (int bj = 0; bj < 2; ++bj)
#pragma unroll
            for (int n = 0; n < 2; ++n) gv[bj][n] = *(const f32x4*)(gate + col0 + bj * HALF + n * 16);
#pragma unroll
        for (int ai = 0; ai < 2; ++ai)
#pragma unroll
            for (int m = 0; m < 4; ++m) { const size_t off = (size_t)(grow0 + ai * HALF + wr * 64 + m * 16 + fr) * 2048 + col0;
#pragma unroll
                for (int bj = 0; bj < 2; ++bj)
#pragma unroll
                    for (int n = 0; n < 2; ++n) { const f32x4 b = *(const f32x4*)(base + off + bj * HALF + n * 16);
                        *(f32x4*)(out + off + bj * HALF + n * 16) = b + gv[bj][n] * acc[ai][bj][m][n]; }
                if (m & 1) asm volatile("" ::: "memory"); }
    }
};
struct SplitKOrder {
    int nN, nsub, ksub, G, c;
    __device__ bool next(int i, Unit& u) const { const int L = i * G + c; if (L >= nsub) return false; u.pm = 0; u.pn = L % nN; u.k0 = (L / nN) * ksub; return true; }
    __device__ __forceinline__ void a_ready(const Unit&) const {}
    __device__ __forceinline__ void done(const Unit&) const {}
};
struct EpiGateAtomic {
    static constexpr bool PERM = false, AFTER_DRAIN = false;
    float* out; const float* gate;
    __device__ __forceinline__ void operator()(const f32x4 (&acc)[2][2][4][2], const Unit& u, int wr, int wc, int fr, int fq) const {
        const int col0 = u.pn * BM + wc * 32 + 4 * fq;
#pragma unroll
        for (int bj = 0; bj < 2; ++bj)
#pragma unroll
            for (int n = 0; n < 2; ++n) { const f32x4 gv = *(const f32x4*)(gate + col0 + bj * HALF + n * 16);
#pragma unroll
                for (int ai = 0; ai < 2; ++ai)
#pragma unroll
                    for (int m = 0; m < 4; ++m) { float* o = out + (size_t)(ai * HALF + wr * 64 + m * 16 + fr) * 2048 + col0 + bj * HALF + n * 16; const f32x4 v = gv * acc[ai][bj][m][n];
                        __hip_atomic_fetch_add(o + 0, v.x, __ATOMIC_RELAXED, __HIP_MEMORY_SCOPE_AGENT); __hip_atomic_fetch_add(o + 1, v.y, __ATOMIC_RELAXED, __HIP_MEMORY_SCOPE_AGENT);
                        __hip_atomic_fetch_add(o + 2, v.z, __ATOMIC_RELAXED, __HIP_MEMORY_SCOPE_AGENT); __hip_atomic_fetch_add(o + 3, v.w, __ATOMIC_RELAXED, __HIP_MEMORY_SCOPE_AGENT); } }
    }
};
struct EpiConvGate {
    static constexpr bool PERM = true, AFTER_DRAIN = false;
    bf16_t* A2; bf16_t* U; const float* cw; const float* cb; int row_off;
    __device__ __forceinline__ void operator()(const f32x4 (&acc)[2][2][4][2], const Unit& u, int wr, int wc, int fr, int fq) const {
        const int lane = fq * 16 + fr;
        const int src_prev = fr > 0 ? lane - 1 : lane + 15, src_next = fr < 15 ? lane + 1 : lane - 15;
        const int ch0 = u.pn * 128 + wc * 32 + 8 * fq;
        const size_t urow0 = (size_t)row_off + (size_t)u.pm * BM + wr * 64 + fr;
#pragma unroll
        for (int n = 0; n < 2; ++n) {
            const int ch = ch0 + 4 * n;
            const f32x4 wa0 = *(const f32x4*)(cw + ch), wa1 = *(const f32x4*)(cw + 11264 + ch), wa2 = *(const f32x4*)(cw + 2 * 11264 + ch), ba = *(const f32x4*)(cb + ch);
            const f32x4 wg0 = *(const f32x4*)(cw + 5632 + ch), wg1 = *(const f32x4*)(cw + 11264 + 5632 + ch), wg2 = *(const f32x4*)(cw + 2 * 11264 + 5632 + ch), bg = *(const f32x4*)(cb + 5632 + ch);
#pragma unroll
            for (int ai = 0; ai < 2; ++ai)
#pragma unroll
                for (int m = 0; m < 4; ++m) {
                    const f32x4 ca = acc[ai][0][m][n], cg = acc[ai][1][m][n];
                    const f32x4 pa_src = (m > 0 && fr == 15) ? acc[ai][0][m > 0 ? m - 1 : 0][n] : ca, pg_src = (m > 0 && fr == 15) ? acc[ai][1][m > 0 ? m - 1 : 0][n] : cg;
                    const f32x4 na_src = (m < 3 && fr == 0) ? acc[ai][0][m < 3 ? m + 1 : 3][n] : ca, ng_src = (m < 3 && fr == 0) ? acc[ai][1][m < 3 ? m + 1 : 3][n] : cg;
                    f32x4 pa, pg, na, ng;
#pragma unroll
                    for (int e = 0; e < 4; ++e) { pa[e] = __shfl(pa_src[e], src_prev); pg[e] = __shfl(pg_src[e], src_prev); na[e] = __shfl(na_src[e], src_next); ng[e] = __shfl(ng_src[e], src_next); }
                    const size_t ur = urow0 + ai * HALF + m * 16;
                    const bool deferred = (m == 0 && fr == 0) || (m == 3 && fr == 15);
                    const bool raw = (m == 0 && fr <= 1) || (m == 3 && fr >= 14);
                    if (raw) { u32x2_t w; w.x = cvt_pk_bf16(ca[0], ca[1]); w.y = cvt_pk_bf16(ca[2], ca[3]); *(u32x2_t*)(U + ur * 11264 + ch) = w;
                               w.x = cvt_pk_bf16(cg[0], cg[1]); w.y = cvt_pk_bf16(cg[2], cg[3]); *(u32x2_t*)(U + ur * 11264 + 5632 + ch) = w; }
                    if (!deferred) {
                        const f32x4 oa = ba + pa * wa0 + ca * wa1 + na * wa2, og = bg + pg * wg0 + cg * wg1 + ng * wg2;
                        f32x4 y;
#pragma unroll
                        for (int e = 0; e < 4; ++e) y[e] = og[e] * __builtin_amdgcn_rcpf(1.f + __expf(-og[e])) * oa[e];
                        u32x2_t w; w.x = cvt_pk_bf16(y[0], y[1]); w.y = cvt_pk_bf16(y[2], y[3]);
                        *(u32x2_t*)(A2 + ur * 5632 + ch) = w;
                    }
                }
        }
    }
};
template <int LAYER> struct EpiQKV {
    static constexpr bool PERM = true, AFTER_DRAIN = false;
    bf16_t* P; const float* gtab; PG8_LAS float* part;
    __device__ __forceinline__ void operator()(const f32x4 (&acc)[2][2][4][2], const Unit& u, int wr, int wc, int fr, int fq) const {
        const int pn = u.pn;
        bool plain, w64, rope; const float* g;
        if (LAYER == 0) { plain = (pn >= 8 && pn < 12) || pn == 17; w64 = pn < 8; rope = true; g = gtab + (pn < 4 ? 0 : 64) + (pn < 8 ? 0 : 64) + (pn < 16 ? 0 : 128); }
        else            { plain = pn == 5 || pn >= 14; w64 = false; rope = pn < 5; g = gtab + (pn < 4 ? 0 : 128) + (pn < 5 ? 0 : 128) + (pn < 10 ? 0 : 128); }
        const int row0 = u.pm * BM + wr * 64 + fr, colw = wc * 32 + 8 * fq;
        bf16_t* base = P + (size_t)row0 * 4608 + (size_t)pn * BM + colw;
        if (plain) {
#pragma unroll
            for (int ai = 0; ai < 2; ++ai)
#pragma unroll
                for (int m = 0; m < 4; ++m)
#pragma unroll
                    for (int bj = 0; bj < 2; ++bj) { const f32x4 v0 = acc[ai][bj][m][0], v1 = acc[ai][bj][m][1];
                        u32x4 w; w.x = cvt_pk_bf16(v0[0], v0[1]); w.y = cvt_pk_bf16(v0[2], v0[3]); w.z = cvt_pk_bf16(v1[0], v1[1]); w.w = cvt_pk_bf16(v1[2], v1[3]);
                        *(u32x4*)(base + (size_t)(ai * HALF + m * 16) * 4608 + bj * HALF) = w; }
            return;
        }
        const bool latent = u.pm > 0;
        PG8_LAS float* pw = part + (wr * 64 + fr) * 8 + wc; const PG8_LAS float* prd = part + (wr * 64 + fr) * 8;
#pragma unroll
        for (int ai = 0; ai < 2; ++ai)
#pragma unroll
            for (int m = 0; m < 4; ++m)
#pragma unroll
                for (int bj = 0; bj < 2; ++bj) { const f32x4 v0 = acc[ai][bj][m][0], v1 = acc[ai][bj][m][1];
                    float s = (v0[0] * v0[0] + v0[1] * v0[1]) + (v0[2] * v0[2] + v0[3] * v0[3]) + (v1[0] * v1[0] + v1[1] * v1[1]) + (v1[2] * v1[2] + v1[3] * v1[3]);
                    s += __shfl_xor(s, 16); s += __shfl_xor(s, 32);
                    if (fq == 0) pw[(ai * HALF + m * 16) * 8 + bj * 4] = s; }
        asm volatile("s_waitcnt lgkmcnt(0)" ::: "memory"); __builtin_amdgcn_s_barrier(); asm volatile("" ::: "memory");
        const int jh = w64 ? ((wc & 1) * 32 + 8 * fq) : colw;
        int dh = jh;
        if (!w64 && rope) { const int b = jh >> 4, bo = (b == 1 || b == 5) ? b + 1 : (b == 2 || b == 6) ? b - 1 : b; dh = bo * 16 + (jh & 15); }
        const f32x4 ga = *(const f32x4*)(g + dh), gb = *(const f32x4*)(g + dh + 4);
        const float gg[8] = {ga[0], ga[1], ga[2], ga[3], gb[0], gb[1], gb[2], gb[3]};
        const bool first = fq < 2;
        const bool colpos = w64 ? (wc & 1) : (wc >> 1);
        float fr8[8];
        { const int i0 = (w64 ? 0 : 16 * (wc & 1)) + 8 * (fq & 1); const float fstep = w64 ? (-13.287712379549449f / 16.f) : (-13.287712379549449f / 32.f);
#pragma unroll
          for (int e8 = 0; e8 < 8; ++e8) fr8[e8] = __builtin_amdgcn_exp2f((float)(i0 + e8) * fstep); }
        const float invw = w64 ? (1.f / 64.f) : (1.f / 128.f);
        const float qs = (LAYER == 0) ? (pn < 4 ? 0.125f * 1.4426950408889634f : (pn >= 12 && pn < 16) ? 0.088388347648318440f * 1.4426950408889634f : 1.f) : 1.f;
#pragma unroll
        for (int ai = 0; ai < 2; ++ai)
#pragma unroll
            for (int m = 0; m < 4; ++m) {
                const int rl = ai * HALF + wr * 64 + m * 16 + fr;
                const int tpos = u.pm * BM + rl - 256;
                const float pos = (float)(colpos ? (tpos & 63) : (tpos >> 6));
#pragma unroll
                for (int bj = 0; bj < 2; ++bj) {
                    const PG8_LAS float* pp = prd + (ai * HALF + m * 16) * 8 + bj * 4;
                    const float ssum = w64 ? (pp[wc & 2] + pp[(wc & 2) + 1]) : ((pp[0] + pp[1]) + (pp[2] + pp[3]));
                    const float rstd = __builtin_amdgcn_rsqf(ssum * invw + 1e-6f);
                    const f32x4 v0 = acc[ai][bj][m][0], v1 = acc[ai][bj][m][1];
                    float x[8] = {v0[0], v0[1], v0[2], v0[3], v1[0], v1[1], v1[2], v1[3]};
#pragma unroll
                    for (int e8 = 0; e8 < 8; ++e8) x[e8] = x[e8] * rstd * gg[e8];
                    if (rope) {
#pragma unroll
                        for (int e8 = 0; e8 < 8; ++e8) { const float other = __shfl_xor(x[e8], 32);
                            const float ang = pos * fr8[e8]; const float cs = __cosf(ang), sn = __sinf(ang);
                            const float rot = first ? x[e8] * cs - other * sn : x[e8] * cs + other * sn;
                            x[e8] = latent ? rot : x[e8]; }
                    }
                    if (LAYER == 0) {
#pragma unroll
                        for (int e8 = 0; e8 < 8; ++e8) x[e8] *= qs; }
                    u32x4 w; w.x = cvt_pk_bf16(x[0], x[1]); w.y = cvt_pk_bf16(x[2], x[3]); w.z = cvt_pk_bf16(x[4], x[5]); w.w = cvt_pk_bf16(x[6], x[7]);
                    *(u32x4*)(base + (size_t)(ai * HALF + m * 16) * 4608 + bj * HALF) = w;
                    asm volatile("" ::: "memory");
                }
            }
    }
};
template <class Epi, class Sched, bool ALIGN_EPI = false, bool SP2 = false>
__device__ __forceinline__ void gemm_phase(PG8_LAS unsigned char* lds, const Gemm g, const Sched& S, const Epi& E) {
    int tid_ = threadIdx.x; asm volatile("" : "+v"(tid_)); const int tid = tid_, wid = __builtin_amdgcn_readfirstlane(tid >> 6), lane = tid & 63, wr = wid >> 2, wc = wid & 3, fr = lane & 15, fq = lane >> 4;
    const int K = g.ld, nt = g.K / BK;
    unsigned voffA[2], voffB[2];
#pragma unroll
    for (int i = 0; i < 2; ++i) { int R, C; stage_rc(tid * 16 + i * 8192, R, C); const int Rb = Epi::PERM ? ((R & ~31) + perm32(R & 31)) : R;
        voffA[i] = (unsigned)(R * K + C) * 2u; voffB[i] = (unsigned)(Rb * K + C) * 2u; }
    const size_t kstep = (size_t)(BK * 2);
    const size_t hstep = (size_t)HALF * K * 2;
    const size_t tstep = 2 * hstep;
    const unsigned ldsw = (unsigned)wid * 1024u;
    const int aoff = lds_byte(wr * 64 + fr, fq * 8), boff = lds_byte(wc * 32 + fr, fq * 8);
#define PG8_SA(b, h) (((b) * 2 + (h)) * HTB)
#define PG8_SB(b, h) ((4 + (b) * 2 + (h)) * HTB)
#define PG8_STAGE(bufoff, gbase, voff) do { _Pragma("unroll") for (int _i = 0; _i < 2; ++_i) \
        __builtin_amdgcn_global_load_lds((const unsigned*)((const char*)(gbase) + (voff)[_i]), (PG8_LAS unsigned*)(lds + (bufoff) + ldsw + _i * 8192), 16, 0, 0); } while (0)
#define PG8_LDA(dst, b, h) do { _Pragma("unroll") for (int m = 0; m < 4; ++m) _Pragma("unroll") for (int k = 0; k < 2; ++k) dst[m][k] = *(const PG8_LAS bf16x8*)(lds + PG8_SA(b, h) + aoff + m * 2048 + k * 1024); } while (0)
#define PG8_LDB(dst, b, h) do { _Pragma("unroll") for (int n = 0; n < 2; ++n) _Pragma("unroll") for (int k = 0; k < 2; ++k) dst[n][k] = *(const PG8_LAS bf16x8*)(lds + PG8_SB(b, h) + boff + n * 2048 + k * 1024); } while (0)
#define PG8_MMA(ai, bj, At, Bt) do { __builtin_amdgcn_s_setprio(1); _Pragma("unroll") for (int m = 0; m < 4; ++m) _Pragma("unroll") for (int n = 0; n < 2; ++n) _Pragma("unroll") for (int k = 0; k < 2; ++k) \
        acc[ai][bj][m][n] = __builtin_amdgcn_mfma_f32_16x16x32_bf16(Bt[n][k], At[m][k], acc[ai][bj][m][n], 0, 0, 0); __builtin_amdgcn_s_setprio(0); } while (0)
#define PG8_WAIT_V(n) asm volatile("s_waitcnt vmcnt(" #n ")" ::: "memory")
#define PG8_WAIT_L(n) asm volatile("s_waitcnt lgkmcnt(" #n ")" ::: "memory")
#define PG8_BAR __builtin_amdgcn_s_barrier()
#define PG8_SCHED __builtin_amdgcn_sched_barrier(0)
    Unit cur, nxt; int ui = 0;
    if (!S.next(0, cur)) return;
    f32x4 acc[2][2][4][2];
#pragma unroll
    for (int a = 0; a < 2; ++a)
#pragma unroll
        for (int b = 0; b < 2; ++b)
#pragma unroll
            for (int m = 0; m < 4; ++m)
#pragma unroll
                for (int n = 0; n < 2; ++n) acc[a][b][m][n] = (f32x4){0.f, 0.f, 0.f, 0.f};
    bf16x8 At[4][2], B0[2][2], B1[2][2];
    const char* cA = (const char*)g.A + (size_t)cur.pm * tstep + (size_t)cur.k0 * 2; const char* cB = (const char*)g.Bt + (size_t)cur.pn * tstep + (size_t)cur.k0 * 2;
    S.a_ready(cur);
    if constexpr (SP2) {
        PG8_STAGE(PG8_SB(0, 0), cB, voffB); PG8_STAGE(PG8_SB(0, 1), cB + hstep, voffB); PG8_STAGE(PG8_SA(0, 0), cA, voffA); PG8_STAGE(PG8_SA(0, 1), cA + hstep, voffA);
        if (wr == 1) PG8_BAR;
        PG8_WAIT_V(2); PG8_BAR;
        PG8_STAGE(PG8_SB(1, 0), cB + kstep, voffB); PG8_STAGE(PG8_SA(1, 0), cA + kstep, voffA); PG8_STAGE(PG8_SB(1, 1), cB + hstep + kstep, voffB);
        PG8_WAIT_V(6); PG8_BAR;
    } else {
        PG8_STAGE(PG8_SB(0, 0), cB, voffB); PG8_STAGE(PG8_SA(0, 0), cA, voffA); PG8_STAGE(PG8_SB(0, 1), cB + hstep, voffB); PG8_STAGE(PG8_SA(0, 1), cA + hstep, voffA);
        if (wr == 1) PG8_BAR;
        PG8_WAIT_V(4); PG8_BAR;
        PG8_STAGE(PG8_SB(1, 0), cB + kstep, voffB); PG8_STAGE(PG8_SA(1, 0), cA + kstep, voffA); PG8_STAGE(PG8_SB(1, 1), cB + hstep + kstep, voffB);
        PG8_WAIT_V(6); PG8_BAR;
    }
    for (;;) {
        const bool has_next = S.next(ui + 1, nxt);
        const char* nA = has_next ? (const char*)g.A + (size_t)nxt.pm * tstep + (size_t)nxt.k0 * 2 : cA; const char* nB = has_next ? (const char*)g.Bt + (size_t)nxt.pn * tstep + (size_t)nxt.k0 * 2 : cB;
        for (int t = 0; t < nt; t += 2) {
            const bool last = (t == nt - 2);
            const char* a1 = cA + (size_t)(t + 1) * kstep;
            const char* a2 = last ? nA : cA + (size_t)(t + 2) * kstep; const char* b2 = last ? nB : cB + (size_t)(t + 2) * kstep;
            const char* a3 = a2 + kstep; const char* b3 = b2 + kstep;
            if (last && has_next) S.a_ready(nxt);
            if constexpr (SP2) {
            PG8_LDB(B0, 0, 0); PG8_LDB(B1, 0, 1); PG8_SCHED; PG8_LDA(At, 0, 0); PG8_STAGE(PG8_SA(1, 1), a1 + hstep, voffA);
            PG8_WAIT_V(8); PG8_WAIT_L(0); PG8_BAR; PG8_MMA(0, 0, At, B0); PG8_MMA(0, 1, At, B1); PG8_BAR; PG8_SCHED;
            PG8_LDA(At, 0, 1); PG8_STAGE(PG8_SB(0, 0), b2, voffB); PG8_STAGE(PG8_SB(0, 1), b2 + hstep, voffB); PG8_STAGE(PG8_SA(0, 0), a2, voffA);
            PG8_WAIT_V(8); PG8_WAIT_L(0); PG8_BAR; PG8_MMA(1, 0, At, B0); PG8_MMA(1, 1, At, B1); PG8_BAR; PG8_SCHED;
            PG8_LDB(B0, 1, 0); PG8_LDB(B1, 1, 1); PG8_SCHED; PG8_LDA(At, 1, 0); PG8_STAGE(PG8_SA(0, 1), a2 + hstep, voffA);
            PG8_WAIT_V(8); PG8_WAIT_L(0); PG8_BAR; PG8_MMA(0, 0, At, B0); PG8_MMA(0, 1, At, B1); PG8_BAR; PG8_SCHED;
            PG8_LDA(At, 1, 1); PG8_STAGE(PG8_SB(1, 0), b3, voffB); PG8_STAGE(PG8_SB(1, 1), b3 + hstep, voffB); PG8_STAGE(PG8_SA(1, 0), a3, voffA);
            PG8_WAIT_V(8); PG8_WAIT_L(0); PG8_BAR; PG8_MMA(1, 0, At, B0); PG8_MMA(1, 1, At, B1); PG8_BAR; PG8_SCHED;
            } else {
            PG8_LDB(B0, 0, 0); PG8_SCHED; PG8_LDA(At, 0, 0); PG8_STAGE(PG8_SA(1, 1), a1 + hstep, voffA);
            PG8_WAIT_L(8); PG8_BAR; PG8_WAIT_L(0); PG8_MMA(0, 0, At, B0); PG8_BAR; PG8_SCHED;
            PG8_LDB(B1, 0, 1); PG8_STAGE(PG8_SB(0, 0), b2, voffB);
            PG8_BAR; PG8_WAIT_L(0); PG8_MMA(0, 1, At, B1); PG8_BAR;
            PG8_LDA(At, 0, 1); PG8_STAGE(PG8_SA(0, 0), a2, voffA);
            PG8_BAR; PG8_WAIT_L(0); PG8_MMA(1, 0, At, B0); PG8_BAR; PG8_SCHED;
            PG8_STAGE(PG8_SB(0, 1), b2 + hstep, voffB);
            PG8_WAIT_V(6); PG8_BAR; PG8_MMA(1, 1, At, B1); PG8_BAR;
            PG8_LDB(B0, 1, 0); PG8_SCHED; PG8_LDA(At, 1, 0); PG8_STAGE(PG8_SA(0, 1), a2 + hstep, voffA);
            PG8_WAIT_L(8); PG8_BAR; PG8_WAIT_L(0); PG8_MMA(0, 0, At, B0); PG8_BAR; PG8_SCHED;
            PG8_LDB(B1, 1, 1); PG8_STAGE(PG8_SB(1, 0), b3, voffB);
            PG8_BAR; PG8_WAIT_L(0); PG8_MMA(0, 1, At, B1); PG8_BAR;
            PG8_LDA(At, 1, 1); PG8_STAGE(PG8_SA(1, 0), a3, voffA);
            PG8_BAR; PG8_WAIT_L(0); PG8_MMA(1, 0, At, B0); PG8_BAR; PG8_SCHED;
            PG8_STAGE(PG8_SB(1, 1), b3 + hstep, voffB);
            PG8_WAIT_V(6); PG8_BAR; PG8_MMA(1, 1, At, B1); PG8_BAR;
            }
        }
        if constexpr (ALIGN_EPI) { if (wr == 0) PG8_BAR; }
        if constexpr (!Epi::AFTER_DRAIN) { E(acc, cur, wr, wc, fr, fq); S.done(cur); }
        if (!has_next) break;
#pragma unroll
        for (int a = 0; a < 2; ++a)
#pragma unroll
            for (int b = 0; b < 2; ++b)
#pragma unroll
                for (int m = 0; m < 4; ++m)
#pragma unroll
                    for (int n = 0; n < 2; ++n) acc[a][b][m][n] = (f32x4){0.f, 0.f, 0.f, 0.f};
        cur = nxt; cA = nA; cB = nB; ++ui;
        if constexpr (ALIGN_EPI) { if (wr == 1) PG8_BAR; }
    }
    PG8_WAIT_V(0);
    if constexpr (!ALIGN_EPI) { if (wr == 0) PG8_BAR; }
    PG8_BAR;
    if constexpr (Epi::AFTER_DRAIN) { E.fused(acc, cur, wr, wc, fr, fq, lds, wid, lane); S.done(cur); }
#undef PG8_SA
#undef PG8_SB
#undef PG8_STAGE
#undef PG8_LDA
#undef PG8_LDB
#undef PG8_MMA
#undef PG8_WAIT_V
#undef PG8_WAIT_L
#undef PG8_BAR
#undef PG8_SCHED
}
}
namespace att {
using bf16 = __hip_bfloat16;
using bf16x8 = __attribute__((ext_vector_type(8))) short;
using s16x4  = __attribute__((ext_vector_type(4))) short;
using f32x16 = __attribute__((ext_vector_type(16))) float;
using u32x4  = __attribute__((ext_vector_type(4))) unsigned;
constexpr int LDP = 4608;
constexpr int LDY = 2048;
constexpr int SHM_V = 64 * 128 * 2, SHM_K = 64 * 128 * 2;
constexpr int NSLOT = 3;
constexpr int OFF_Q = 2 * SHM_V + 2 * SHM_K;
constexpr int OFF_WS = 131072, OFF_TAB = OFF_WS + 8 * 64 * 4, ATT_LDS = OFF_TAB + 2048;
constexpr float THR = 8.f;


#define SBAR() __builtin_amdgcn_sched_barrier(0)
__device__ __forceinline__ int crow(int r, int hi) { return (r & 3) + 8 * (r >> 2) + 4 * hi; }
__device__ __forceinline__ unsigned cvtpk(float lo, float hi) { unsigned r; asm volatile("v_cvt_pk_bf16_f32 %0, %1, %2" : "=v"(r) : "v"(lo), "v"(hi)); return r; }
__device__ __forceinline__ bf16x8 ld8(const bf16* p) { return *reinterpret_cast<const bf16x8*>(p); }
template <int DQK> __device__ __forceinline__ int kswz(int row, int colB) {
  if constexpr (DQK == 128) return row * 256 + (colB ^ ((((row & 7) | (((row >> 4) & 1) << 3))) << 4));
  else return row * 128 + (colB ^ (((((row >> 1) & 3) | (((row >> 4) & 1) << 2))) << 4));
}

template <int DQK> __device__ __forceinline__ void partialSM(f32x16& p0, f32x16& p1, float& m_reg, float& mn, float& alpha) {
  constexpr float SCALE = (DQK == 128) ? 0.088388347648318440f : 0.125f;
  constexpr float C = SCALE * 1.4426950408889634f;
  float pmax = p0[0];
#pragma unroll
  for (int r = 1; r < 16; ++r) pmax = fmaxf(pmax, p0[r]);
#pragma unroll
  for (int r = 0; r < 16; ++r) pmax = fmaxf(pmax, p1[r]);
  { auto rr = __builtin_amdgcn_permlane32_swap(__float_as_uint(pmax), __float_as_uint(pmax), false, false);
    pmax = fmaxf(__uint_as_float(rr[0]), __uint_as_float(rr[1])); }
  if (__builtin_expect(__all(pmax - m_reg <= THR / SCALE), 1)) { mn = m_reg; alpha = 1.f; }
  else { mn = fmaxf(m_reg, pmax); alpha = __builtin_amdgcn_exp2f((m_reg - mn) * C); m_reg = mn; }
  float mnC = -mn * C;
#pragma unroll
  for (int r = 0; r < 16; ++r) p0[r] = fmaf(p0[r], C, mnC);
#pragma unroll
  for (int r = 0; r < 16; ++r) p1[r] = fmaf(p1[r], C, mnC);
#pragma unroll
  for (int r = 0; r < 16; ++r) p0[r] = __builtin_amdgcn_exp2f(p0[r]);
}
__device__ __forceinline__ void finishSM(f32x16& p0, f32x16& p1, float alpha, float& l_reg, bf16x8& pa0, bf16x8& pa1, bf16x8& pa2, bf16x8& pa3) {
#pragma unroll
  for (int r = 0; r < 16; ++r) p1[r] = __builtin_amdgcn_exp2f(p1[r]);
  float ps = 0;
#pragma unroll
  for (int r = 0; r < 16; ++r) ps += p0[r];
#pragma unroll
  for (int r = 0; r < 16; ++r) ps += p1[r];
  { auto rr = __builtin_amdgcn_permlane32_swap(__float_as_uint(ps), __float_as_uint(ps), false, false);
    ps = __uint_as_float(rr[0]) + __uint_as_float(rr[1]); }
  l_reg = l_reg * alpha + ps;
#define PK4(P, BASE, OUT) do { unsigned a0 = cvtpk(P[BASE + 0], P[BASE + 1]), a1 = cvtpk(P[BASE + 2], P[BASE + 3]);   \
    unsigned b0 = cvtpk(P[BASE + 4], P[BASE + 5]), b1 = cvtpk(P[BASE + 6], P[BASE + 7]);                              \
    auto r0 = __builtin_amdgcn_permlane32_swap(a0, b0, false, false); auto r1 = __builtin_amdgcn_permlane32_swap(a1, b1, false, false); \
    u32x4 w = {r0[0], r1[0], r0[1], r1[1]}; OUT = *reinterpret_cast<bf16x8*>(&w); } while (0)
  PK4(p0, 0, pa0); PK4(p0, 8, pa1); PK4(p1, 0, pa2); PK4(p1, 8, pa3);
#undef PK4
}
template <int DQK, bool QREG> __device__ __forceinline__ void qkt(f32x16& p0, f32x16& p1, const bf16* Ks, const bf16x8* qr, const char* Qimg, int r32, int hi) {
  p0 = f32x16{}; p1 = f32x16{};
#pragma unroll
  for (int d0 = 0; d0 < DQK / 16; ++d0) { int cb = (d0 * 16 + hi * 8) * 2;
    bf16x8 q; if constexpr (QREG) q = qr[d0]; else q = *reinterpret_cast<const bf16x8*>(Qimg + d0 * 1024);
    bf16x8 b0 = *reinterpret_cast<const bf16x8*>((const char*)Ks + kswz<DQK>(r32, cb));
    bf16x8 b1 = *reinterpret_cast<const bf16x8*>((const char*)Ks + kswz<DQK>(32 + r32, cb));
    p0 = __builtin_amdgcn_mfma_f32_32x32x16_bf16(b0, q, p0, 0, 0, 0);
    p1 = __builtin_amdgcn_mfma_f32_32x32x16_bf16(b1, q, p1, 0, 0, 0); }
}
__device__ __forceinline__ int v_st(int k, int c) { const int kk = (k & ~0xC) | ((k & 4) << 1) | ((k & 8) >> 1); return ((kk >> 3) * 4 + (c >> 5)) * 512 + ((kk & 7) * 32 + (c & 31)) * 2; }
__device__ __forceinline__ int v_rd_base(int lane) { return ((lane & 3) << 3) | (((lane >> 2) & 3) << 6) | (((lane >> 4) & 1) << 5) | (((lane >> 5) & 1) << 8); }
constexpr int v_rd_off(int d0, int ks, int half) { return d0 * 512 + ks * 4096 + half * 2048; }
template <int OFF> __device__ __forceinline__ s16x4 tr_read(int vb) {
  s16x4 r; asm volatile("ds_read_b64_tr_b16 %0, %1 offset:%2" : "=&v"(r) : "v"(vb), "i"(OFF) : "memory"); return r;
}
template <int D0> __device__ __forceinline__ void pv_one(f32x16& od, int vb, bf16x8 pa0, bf16x8 pa1, bf16x8 pa2, bf16x8 pa3) {
  const s16x4 l0 = tr_read<v_rd_off(D0, 0, 0)>(vb), h0 = tr_read<v_rd_off(D0, 0, 1)>(vb), l1 = tr_read<v_rd_off(D0, 1, 0)>(vb), h1 = tr_read<v_rd_off(D0, 1, 1)>(vb);
  const s16x4 l2 = tr_read<v_rd_off(D0, 2, 0)>(vb), h2 = tr_read<v_rd_off(D0, 2, 1)>(vb), l3 = tr_read<v_rd_off(D0, 3, 0)>(vb), h3 = tr_read<v_rd_off(D0, 3, 1)>(vb);
  asm volatile("s_waitcnt lgkmcnt(0)" ::: "memory"); SBAR();
#define PK(L, H) (bf16x8){L[0], L[1], L[2], L[3], H[0], H[1], H[2], H[3]}
  od = __builtin_amdgcn_mfma_f32_32x32x16_bf16(pa0, PK(l0, h0), od, 0, 0, 0);
  od = __builtin_amdgcn_mfma_f32_32x32x16_bf16(pa1, PK(l1, h1), od, 0, 0, 0);
  od = __builtin_amdgcn_mfma_f32_32x32x16_bf16(pa2, PK(l2, h2), od, 0, 0, 0);
  od = __builtin_amdgcn_mfma_f32_32x32x16_bf16(pa3, PK(l3, h3), od, 0, 0, 0);
#undef PK
}
__device__ __forceinline__ void pv_d0(f32x16* o, int vb, bf16x8 pa0, bf16x8 pa1, bf16x8 pa2, bf16x8 pa3) {
  pv_one<0>(o[0], vb, pa0, pa1, pa2, pa3); pv_one<1>(o[1], vb, pa0, pa1, pa2, pa3); pv_one<2>(o[2], vb, pa0, pa1, pa2, pa3); pv_one<3>(o[3], vb, pa0, pa1, pa2, pa3);
}

__device__ __forceinline__ void glds16(const void* gsrc, unsigned lds_dst) { unsigned keep;
  asm volatile("s_mov_b32 %0, m0\n\ts_mov_b32 m0, %2\n\ts_nop 0\n\tglobal_load_lds_dwordx4 %1, off\n\ts_mov_b32 m0, %0" : "=&s"(keep) : "v"(gsrc), "s"(lds_dst) : "memory"); }
struct MaskCtx { int a, b, c; const float* tab; };
template <int MODE> __device__ __forceinline__ void apply_mask(f32x16& p0, f32x16& p1, int j, const MaskCtx& mc, int hi) {
  if constexpr (MODE == 0) return;
  if (j < 4) return;
  if constexpr (MODE == 1) {
    const int kt0 = mc.b + (j - 4) * 64;
#pragma unroll
    for (int r = 0; r < 16; ++r) {
      const int k0 = kt0 + crow(r, hi), k1 = k0 + 32;
      const int d0 = mc.a - k0, d1 = mc.a - k1;
      const bool v0 = (d0 <= 128) && (d0 >= -128) && (k0 >= 0) && (k0 < 8192);
      const bool v1 = (d1 <= 128) && (d1 >= -128) && (k1 >= 0) && (k1 < 8192);
      p0[r] = v0 ? p0[r] : -1e30f; p1[r] = v1 ? p1[r] : -1e30f;
    }
  } else if constexpr (MODE == 2) {
    const int kr = mc.c + (j - 4);
    const int rs = min(max(mc.a - 4, 0), 120);
    const bool rv = (kr >= rs) && (kr < rs + 8);
    const int cs = min(max(mc.b - 8, 0), 48);
    const int tb = (rv ? (kr - mc.a + 7) : 7) * 31 - mc.b + 15;
#pragma unroll
    for (int r = 0; r < 16; ++r) {
      const int c0 = crow(r, hi), c1 = c0 + 32;
      const bool v0 = rv && (c0 >= cs) && (c0 < cs + 16);
      const bool v1 = rv && (c1 >= cs) && (c1 < cs + 16);
      const float b0 = mc.tab[v0 ? tb + c0 : 0], b1 = mc.tab[v1 ? tb + c1 : 0];
      p0[r] = v0 ? p0[r] + b0 : -1e30f; p1[r] = v1 ? p1[r] + b1 : -1e30f;
    }
  }
}

template <int DQK, int MODE>
__device__ __forceinline__ void pv_partial(f32x16* o, int vb, bf16x8 pa0, bf16x8 pa1, bf16x8 pa2, bf16x8 pa3, f32x16& p0, f32x16& p1, float& m_reg, float& mn, float& alpha, int j, const MaskCtx& mc, int hi) {
  constexpr float SCALE = (DQK == 128) ? 0.088388347648318440f : 0.125f;
  constexpr float C = SCALE * 1.4426950408889634f;
  apply_mask<MODE>(p0, p1, j, mc, hi);
  pv_one<0>(o[0], vb, pa0, pa1, pa2, pa3);
  float pm0 = p0[0];
#pragma unroll
  for (int r = 1; r < 16; ++r) pm0 = fmaxf(pm0, p0[r]);
  SBAR();
  pv_one<1>(o[1], vb, pa0, pa1, pa2, pa3);
  float pmax = pm0;
#pragma unroll
  for (int r = 0; r < 16; ++r) pmax = fmaxf(pmax, p1[r]);
  { auto rr = __builtin_amdgcn_permlane32_swap(__float_as_uint(pmax), __float_as_uint(pmax), false, false);
    pmax = fmaxf(__uint_as_float(rr[0]), __uint_as_float(rr[1])); }
  if (__builtin_expect(__all(pmax - m_reg <= THR / SCALE), 1)) { mn = m_reg; alpha = 1.f; }
  else { mn = fmaxf(m_reg, pmax); alpha = __builtin_amdgcn_exp2f((m_reg - mn) * C); m_reg = mn; }
  const float mnC = -mn * C;
  SBAR();
  pv_one<2>(o[2], vb, pa0, pa1, pa2, pa3);
#pragma unroll
  for (int r = 0; r < 16; ++r) p0[r] = fmaf(p0[r], C, mnC);
#pragma unroll
  for (int r = 0; r < 16; ++r) p1[r] = fmaf(p1[r], C, mnC);
  SBAR();
  pv_one<3>(o[3], vb, pa0, pa1, pa2, pa3);
#pragma unroll
  for (int r = 0; r < 16; ++r) p0[r] = __builtin_amdgcn_exp2f(p0[r]);
}

template <int DQK> __device__ __forceinline__ void qkt_n(f32x16& p0, f32x16& p1, const bf16* Ks, const bf16x8* qr, const f32x16& negm, int r32, int hi) {
#pragma unroll
  for (int d0 = 0; d0 < DQK / 16; ++d0) { int cb = (d0 * 16 + hi * 8) * 2;
    bf16x8 b0 = *reinterpret_cast<const bf16x8*>((const char*)Ks + kswz<DQK>(r32, cb));
    bf16x8 b1 = *reinterpret_cast<const bf16x8*>((const char*)Ks + kswz<DQK>(32 + r32, cb));
    if (d0 == 0) { p0 = __builtin_amdgcn_mfma_f32_32x32x16_bf16(b0, qr[0], negm, 0, 0, 0); p1 = __builtin_amdgcn_mfma_f32_32x32x16_bf16(b1, qr[0], negm, 0, 0, 0); }
    else { p0 = __builtin_amdgcn_mfma_f32_32x32x16_bf16(b0, qr[d0], p0, 0, 0, 0); p1 = __builtin_amdgcn_mfma_f32_32x32x16_bf16(b1, qr[d0], p1, 0, 0, 0); } }
}
__device__ __forceinline__ void pv_partial_n(f32x16* o, int vb, bf16x8 pa0, bf16x8 pa1, bf16x8 pa2, bf16x8 pa3, f32x16& p0, f32x16& p1, float& mref, f32x16& negm, float& alpha) {
  constexpr float THRL = THR * 1.4426950408889634f;
  pv_one<0>(o[0], vb, pa0, pa1, pa2, pa3);
  float pm0 = p0[0];
#pragma unroll
  for (int r = 1; r < 16; ++r) pm0 = fmaxf(pm0, p0[r]);
  SBAR();
  pv_one<1>(o[1], vb, pa0, pa1, pa2, pa3);
  float pmax = pm0;
#pragma unroll
  for (int r = 0; r < 16; ++r) pmax = fmaxf(pmax, p1[r]);
  { auto rr = __builtin_amdgcn_permlane32_swap(__float_as_uint(pmax), __float_as_uint(pmax), false, false);
    pmax = fmaxf(__uint_as_float(rr[0]), __uint_as_float(rr[1])); }
  alpha = 1.f;
  if (__builtin_expect(!__all(pmax <= THRL), 0)) {
    const float dl = fmaxf(pmax, 0.f); mref += dl;
#pragma unroll
    for (int r = 0; r < 16; ++r) { p0[r] -= dl; p1[r] -= dl; }
#pragma unroll
    for (int r = 0; r < 16; ++r) negm[r] = -mref;
    alpha = __builtin_amdgcn_exp2f(-dl);
  }
  SBAR();
  pv_one<2>(o[2], vb, pa0, pa1, pa2, pa3);
  SBAR();
  pv_one<3>(o[3], vb, pa0, pa1, pa2, pa3);
#pragma unroll
  for (int r = 0; r < 16; ++r) p0[r] = __builtin_amdgcn_exp2f(p0[r]);
}

template <int DQK, int MODE>
__device__ __forceinline__ void attn_core(const bf16* __restrict__ Qb, const bf16* __restrict__ Kh, const bf16* __restrict__ Vh, const int NT, const int band0,
                                          const MaskCtx& mc, char* lds, f32x16 (&o)[4], float& m_reg, float& l_reg) {
  int tid_ = threadIdx.x; asm volatile("" : "+v"(tid_));
  const int tid = tid_, wid = tid >> 6, lane = tid & 63, r32 = lane & 31, hi = lane >> 5;
  constexpr int NSL = (MODE == 0) ? NSLOT : 2;
  bf16* V_lds = (bf16*)lds; bf16* K_lds = (bf16*)(lds + NSL * SHM_V);
  float* ws = (float*)(lds + OFF_WS) + wid * 64; float* al_l = ws + 32;
  m_reg = -1e30f; l_reg = 0.f;
#pragma unroll
  for (int d = 0; d < 4; ++d) o[d] = f32x16{};
  constexpr bool QREG = (MODE == 0);
  constexpr int SDEPTH = (MODE == 0) ? 2 : 1;
  bf16x8 qr[DQK / 16];
  const bf16* Qw = Qb + (long)(wid * 32 + r32) * LDP + hi * 8;
#pragma unroll
  for (int d0 = 0; d0 < DQK / 16; ++d0) qr[d0] = ld8(Qw + d0 * 16);
  char* Qimg = lds + OFF_Q + wid * 8192 + lane * 16;
  const int sr = tid >> 4, sc = (tid & 15) * 8, vst0 = v_st(sr, sc), vst1 = v_st(32 + sr, sc);
  const int kr64 = tid >> 3, kc64 = (tid & 7) * 8;
  const int vb0 = (int)(uintptr_t)V_lds + v_rd_base(lane);
  struct { bf16x8 vs0, vs1, ks0, ks1; } sr_[SDEPTH];
#define TROW(j) ((MODE == 0 || (j) < 4) ? (j) * 64 : band0 + ((j) - 4) * 64)
  const unsigned offv0 = (unsigned)(sr * LDP + sc), offv1 = (unsigned)((32 + sr) * LDP + sc), offk64 = (unsigned)(kr64 * LDP + kc64);
#define SLOAD(i, j) do { const long k0_ = (long)TROW(j) * LDP; const bf16* vt_ = Vh + k0_; const bf16* kt_ = Kh + k0_; \
    sr_[i].vs0 = ld8(vt_ + offv0); sr_[i].vs1 = ld8(vt_ + offv1); \
    if constexpr (DQK == 128) { sr_[i].ks0 = ld8(kt_ + offv0); sr_[i].ks1 = ld8(kt_ + offv1); } \
    else { sr_[i].ks0 = ld8(kt_ + offk64); } } while (0)
#define SWRITE(so, i) do { *(bf16x8*)((char*)V_lds + (so) + vst0) = sr_[i].vs0; *(bf16x8*)((char*)V_lds + (so) + vst1) = sr_[i].vs1; \
    if constexpr (DQK == 128) { *(bf16x8*)((char*)K_lds + (so) + kswz<128>(sr, sc * 2)) = sr_[i].ks0; *(bf16x8*)((char*)K_lds + (so) + kswz<128>(32 + sr, sc * 2)) = sr_[i].ks1; } \
    else { *(bf16x8*)((char*)K_lds + (so) + kswz<64>(kr64, kc64 * 2)) = sr_[i].ks0; } } while (0)
#define SWAIT() do { if constexpr (SDEPTH == 2) asm volatile("s_waitcnt vmcnt(4)" ::: "memory"); else asm volatile("s_waitcnt vmcnt(0)" ::: "memory"); } while (0)
#define RESC(a) do { if (__any((a) < 1.f)) { if (hi == 0) al_l[r32] = (a); asm volatile("s_waitcnt lgkmcnt(0)" ::: "memory"); \
    _Pragma("unroll") for (int d = 0; d < 4; ++d) _Pragma("unroll") for (int r = 0; r < 16; ++r) o[d][r] *= al_l[crow(r, hi)]; } } while (0)
  f32x16 pA0, pA1, pB0, pB1; float mnA, mnB, alA, alB; bf16x8 pa0, pa1, pa2, pa3;
  if constexpr (MODE == 0) {
    const int widu = __builtin_amdgcn_readfirstlane(wid);
    constexpr int NKI = DQK / 64, NVI = 2;
    unsigned koff[NKI], voff[NVI];
#pragma unroll
    for (int i = 0; i < NKI; ++i) { const int p16 = (widu * NKI + i) * 64 + lane;
      if constexpr (DQK == 128) { const int row = p16 >> 4, slot = p16 & 15, f = (row & 7) | (((row >> 4) & 1) << 3); koff[i] = (unsigned)(row * LDP + ((slot ^ f) << 3)); }
      else                      { const int row = p16 >> 3, slot = p16 & 7,  f = ((row >> 1) & 3) | (((row >> 4) & 1) << 2); koff[i] = (unsigned)(row * LDP + ((slot ^ f) << 3)); } }
#pragma unroll
    for (int i = 0; i < NVI; ++i) { const int off = ((widu * NVI + i) * 64 + lane) * 16, sub = off >> 9, within = (off & 511) >> 1;
      const int kk = (sub >> 2) * 8 + (within >> 5), k = (kk & ~0xC) | ((kk & 4) << 1) | ((kk & 8) >> 1), c = (sub & 3) * 32 + (within & 31);
      voff[i] = (unsigned)(k * LDP + c); }
    const unsigned ldsV = (unsigned)(uintptr_t)V_lds + (unsigned)widu * (NVI * 1024u), ldsK = (unsigned)(uintptr_t)K_lds + (unsigned)widu * (NKI * 1024u);
#define DMA_TILE(jj, so) do { const long k0_ = (long)(jj) * 64 * LDP; const bf16* vt_ = Vh + k0_; const bf16* kt_ = Kh + k0_; \
    _Pragma("unroll") for (int i_ = 0; i_ < NKI; ++i_) glds16(kt_ + koff[i_], (unsigned)__builtin_amdgcn_readfirstlane(ldsK + (unsigned)(so) + i_ * 1024u)); \
    _Pragma("unroll") for (int i_ = 0; i_ < NVI; ++i_) glds16(vt_ + voff[i_], (unsigned)__builtin_amdgcn_readfirstlane(ldsV + (unsigned)(so) + i_ * 1024u)); } while (0)
#define VMWAIT0() asm volatile("s_waitcnt vmcnt(0)" ::: "memory")
#define RESCD(a) do { if (__any((a) < 1.f)) { if (hi == 0) al_l[r32] = (a); asm volatile("s_waitcnt lgkmcnt(0)" ::: "memory"); \
    _Pragma("unroll") for (int d = 0; d < 4; ++d) _Pragma("unroll") for (int r = 0; r < 16; ++r) o[d][r] *= al_l[crow(r, hi)]; } } while (0)
    int s_prev = 0, s_cur = SHM_V, s_next = 2 * SHM_V;
    float mref = 0.f; f32x16 negm = f32x16{}; asm volatile("" : "+v"(negm));
    __syncthreads();
    DMA_TILE(0, 0); VMWAIT0(); __syncthreads();
    DMA_TILE(1, SHM_V);
    qkt_n<DQK>(pA0, pA1, K_lds, qr, negm, r32, hi);
    {
      constexpr float THRL = THR * 1.4426950408889634f;
      float pmax = pA0[0];
#pragma unroll
      for (int r = 1; r < 16; ++r) pmax = fmaxf(pmax, pA0[r]);
#pragma unroll
      for (int r = 0; r < 16; ++r) pmax = fmaxf(pmax, pA1[r]);
      { auto rr = __builtin_amdgcn_permlane32_swap(__float_as_uint(pmax), __float_as_uint(pmax), false, false); pmax = fmaxf(__uint_as_float(rr[0]), __uint_as_float(rr[1])); }
      alA = 1.f;
      if (!__all(pmax <= THRL)) { const float dl = fmaxf(pmax, 0.f); mref += dl;
#pragma unroll
        for (int r = 0; r < 16; ++r) { pA0[r] -= dl; pA1[r] -= dl; }
#pragma unroll
        for (int r = 0; r < 16; ++r) negm[r] = -mref; }
#pragma unroll
      for (int r = 0; r < 16; ++r) pA0[r] = __builtin_amdgcn_exp2f(pA0[r]);
    }
    VMWAIT0(); __syncthreads();
    for (int j = 1; j + 1 < NT; j += 2) {
      DMA_TILE(j + 1, s_next);
      SBAR(); qkt_n<DQK>(pB0, pB1, (bf16*)((char*)K_lds + s_cur), qr, negm, r32, hi);
      finishSM(pA0, pA1, alA, l_reg, pa0, pa1, pa2, pa3); SBAR();
      pv_partial_n(o, vb0 + s_prev, pa0, pa1, pa2, pa3, pB0, pB1, mref, negm, alB);
      RESCD(alB); VMWAIT0(); __syncthreads();
      { const int t_ = s_prev; s_prev = s_cur; s_cur = s_next; s_next = t_; }
      if (j + 2 < NT) DMA_TILE(j + 2, s_next);
      SBAR(); qkt_n<DQK>(pA0, pA1, (bf16*)((char*)K_lds + s_cur), qr, negm, r32, hi);
      finishSM(pB0, pB1, alB, l_reg, pa0, pa1, pa2, pa3); SBAR();
      pv_partial_n(o, vb0 + s_prev, pa0, pa1, pa2, pa3, pA0, pA1, mref, negm, alA);
      RESCD(alA); VMWAIT0(); __syncthreads();
      { const int t_ = s_prev; s_prev = s_cur; s_cur = s_next; s_next = t_; }
    }
    SBAR(); qkt_n<DQK>(pB0, pB1, (bf16*)((char*)K_lds + s_cur), qr, negm, r32, hi);
    finishSM(pA0, pA1, alA, l_reg, pa0, pa1, pa2, pa3); SBAR();
    pv_partial_n(o, vb0 + s_prev, pa0, pa1, pa2, pa3, pB0, pB1, mref, negm, alB);
    RESCD(alB);
    finishSM(pB0, pB1, alB, l_reg, pa0, pa1, pa2, pa3); SBAR();
    pv_d0(o, vb0 + s_cur, pa0, pa1, pa2, pa3);
    m_reg = mref;
#undef DMA_TILE
#undef VMWAIT0
#undef RESCD
    return;
  }
  constexpr int SE = 0, SO = SDEPTH - 1;
  int s_prev = 0, s_cur = SHM_V, s_next = (NSL == 3) ? 2 * SHM_V : 0;
#define ROT() do { const int t_ = s_prev; s_prev = s_cur; s_cur = s_next; s_next = (NSL == 3) ? t_ : s_prev; } while (0)
  __syncthreads();
  if constexpr (!QREG) {
#pragma unroll
    for (int d0 = 0; d0 < DQK / 16; ++d0) *reinterpret_cast<bf16x8*>(Qimg + d0 * 1024) = qr[d0];
    asm volatile("s_waitcnt lgkmcnt(0)" ::: "memory");
  }
  SLOAD(SE, 0); asm volatile("s_waitcnt vmcnt(0)" ::: "memory"); SWRITE(0, SE); __syncthreads();
  qkt<DQK, QREG>(pA0, pA1, K_lds, qr, Qimg, r32, hi); apply_mask<MODE>(pA0, pA1, 0, mc, hi); partialSM<DQK>(pA0, pA1, m_reg, mnA, alA);
  SLOAD(SO, 1); if constexpr (SDEPTH == 2) { if (2 < NT) SLOAD(SE, 2); }
  SWAIT(); SWRITE(SHM_V, SO); __syncthreads();
  for (int j = 1; j + 1 < NT; j += 2) {
    SBAR(); qkt<DQK, QREG>(pB0, pB1, (bf16*)((char*)K_lds + s_cur), qr, Qimg, r32, hi);
    finishSM(pA0, pA1, alA, l_reg, pa0, pa1, pa2, pa3); SBAR();
    SLOAD(SO, j + SDEPTH); SBAR();
    pv_partial<DQK, MODE>(o, vb0 + s_prev, pa0, pa1, pa2, pa3, pB0, pB1, m_reg, mnB, alB, j, mc, hi);
    if constexpr (NSL == 2) __syncthreads();
    SWAIT(); SWRITE(s_next, SE);
    RESC(alB); __syncthreads(); ROT();
    SBAR(); qkt<DQK, QREG>(pA0, pA1, (bf16*)((char*)K_lds + s_cur), qr, Qimg, r32, hi);
    finishSM(pB0, pB1, alB, l_reg, pa0, pa1, pa2, pa3); SBAR();
    if (SDEPTH == 1 || j + 3 < NT) SLOAD(SE, j + 1 + SDEPTH); SBAR();
    pv_partial<DQK, MODE>(o, vb0 + s_prev, pa0, pa1, pa2, pa3, pA0, pA1, m_reg, mnA, alA, j + 1, mc, hi);
    if constexpr (NSL == 2) __syncthreads();
    SWAIT(); SWRITE(s_next, SO);
    RESC(alA); __syncthreads(); ROT();
  }
  SBAR(); qkt<DQK, QREG>(pB0, pB1, (bf16*)((char*)K_lds + s_cur), qr, Qimg, r32, hi);
  finishSM(pA0, pA1, alA, l_reg, pa0, pa1, pa2, pa3); SBAR();
  pv_partial<DQK, MODE>(o, vb0 + s_prev, pa0, pa1, pa2, pa3, pB0, pB1, m_reg, mnB, alB, NT - 1, mc, hi);
  RESC(alB);
  finishSM(pB0, pB1, alB, l_reg, pa0, pa1, pa2, pa3); SBAR();
  pv_d0(o, vb0 + s_cur, pa0, pa1, pa2, pa3);
  asm volatile("s_waitcnt vmcnt(0)" ::: "memory");
#undef ROT
#undef TROW
#undef SLOAD
#undef SWRITE
#undef SWAIT
#undef RESC
}

__device__ __forceinline__ void row_recips(float l, float* li_l, int r32, int hi, float (&rli)[16]) {
  if (hi == 0) li_l[r32] = l;
  asm volatile("s_waitcnt lgkmcnt(0)" ::: "memory");
#pragma unroll
  for (int r = 0; r < 16; ++r) rli[r] = __builtin_amdgcn_rcpf(li_l[crow(r, hi)]);
  asm volatile("s_waitcnt lgkmcnt(0)" ::: "memory");
}
__device__ __forceinline__ unsigned short f2bf16(float f) { unsigned u = __builtin_bit_cast(unsigned, f); return (unsigned short)((u + 0x7fffu + ((u >> 16) & 1u)) >> 16); }
#undef SBAR
}
#define LAS __attribute__((address_space(3)))
typedef unsigned short bf16_t;
typedef unsigned v4u __attribute__((ext_vector_type(4)));
typedef unsigned v2u __attribute__((ext_vector_type(2)));
typedef float f32x4 __attribute__((ext_vector_type(4)));
constexpr int NWAVES = 8, NTHR = 512;
constexpr int DM = 2048, SEQ = 8192, CTX = 256, MTOT = SEQ + CTX, INW = 4608, DFF = 5632, UPW = 2 * DFF, NMODC = 6 * DM;
constexpr float EPS = 1e-6f;
constexpr size_t MiB = 1u << 20;
constexpr size_t WS_MOD = 0;
constexpr size_t MOD_BYTES = (size_t)2 * 2 * NMODC * 4;
constexpr size_t WS_BAR = 256 * 1024, CTL_ZERO_BYTES = 512 * 1024;
constexpr size_t WS_GTAB = 384 * 1024;
constexpr int MISC_OFF = 145408;
constexpr size_t WS_WIN = 1 * MiB, WS_WOUT = WS_WIN + 36 * MiB, WS_WUP = WS_WOUT + 16 * MiB, WS_WDN = WS_WUP + 88 * MiB;
constexpr size_t WS_H = WS_WDN + 44 * MiB, WS_XR = WS_H + 33 * MiB, WS_A2 = WS_XR + 66 * MiB, WS_U = WS_A2 + 91 * MiB, WS_END = WS_U + 182 * MiB;
constexpr size_t WS_P = WS_U, WS_Y = WS_U + 76 * MiB, WS_O1 = WS_U + 109 * MiB;
static_assert((size_t)(MTOT + 128) * INW * 2 <= 76 * MiB && (size_t)MTOT * DM * 2 <= 33 * MiB && WS_O1 + 256 * 262144 <= WS_END, "overlay map");
static_assert((size_t)MTOT * UPW * 2 <= 182 * MiB && (size_t)MTOT * DFF * 2 <= 91 * MiB && (size_t)MTOT * DM * 4 <= 66 * MiB, "ws map");
constexpr int LDS_BYTES = 147456;

struct Params {
    const float *x, *c, *ctx, *c_ctx, *w_ada, *b_ada, *norm1_g, *w_in, *w_out, *a_qk_g, *a_lambda, *a_subln_g, *b_qk_g, *c_qk_g, *c_sink, *d_qk_g, *d_rpb, *norm2_g, *w_up, *conv_w, *conv_b, *w_down;
    float* out; unsigned char* ws;
};

#define LDS_WAIT() asm volatile("s_waitcnt lgkmcnt(0)" ::: "memory")
__device__ __forceinline__ unsigned f2bf(float f) { unsigned u = __builtin_bit_cast(unsigned, f); return (u + 0x7fffu + ((u >> 16) & 1u)) >> 16; }
__device__ __forceinline__ unsigned pk2(float lo, float hi) { return f2bf(lo) | (f2bf(hi) << 16); }
__device__ __forceinline__ float bf_lo(unsigned w) { return __builtin_bit_cast(float, w << 16); }
__device__ __forceinline__ float bf_hi(unsigned w) { return __builtin_bit_cast(float, w & 0xffff0000u); }
__device__ __forceinline__ float wave_sum(float v) {
#pragma unroll
    for (int o = 1; o < 64; o <<= 1) v += __shfl_xor(v, o);
    return v;
}
__device__ __forceinline__ float silu_f(float v) { return v / (1.f + __expf(-v)); }

__device__ __forceinline__ void transpose_item(const float* __restrict__ W, int K, int N, bf16_t* __restrict__ WT, LAS float* scr, int item, int lane, bool remap_up = false, bool swap_mid = false) {
    const int nblk = N / 64, kb = item / nblk, nb = item % nblk, k0 = 64 * kb, n0 = 64 * nb;
    f32x4 v[16];
#pragma unroll
    for (int i = 0; i < 16; ++i) v[i] = *(const f32x4*)(W + (size_t)(k0 + 4 * i + (lane >> 4)) * N + n0 + (lane & 15) * 4);
#pragma unroll
    for (int i = 0; i < 16; ++i) { LAS float* s = scr + (4 * i + (lane >> 4)) * 65 + (lane & 15) * 4; s[0] = v[i].x; s[1] = v[i].y; s[2] = v[i].z; s[3] = v[i].w; }
    LDS_WAIT();
    const int c = lane & 7;
    const int d0 = !remap_up ? n0 : (n0 < DFF ? 256 * (n0 / 128) + (n0 % 128) : 256 * ((n0 - DFF) / 128) + 128 + ((n0 - DFF) % 128));
#pragma unroll
    for (int j = 0; j < 8; ++j) { const int n = (lane >> 3) + 8 * j; const LAS float* s = scr + (8 * c) * 65 + n;
        v4u o; o.x = pk2(s[0], s[65]); o.y = pk2(s[130], s[195]); o.z = pk2(s[260], s[325]); o.w = pk2(s[390], s[455]);
        const int nd = swap_mid ? ((((n >> 4) == 1) ? 32 : ((n >> 4) == 2) ? 16 : (n & 48)) + (n & 15)) : n;
        *(v4u*)(WT + (size_t)(d0 + nd) * K + k0 + 8 * c) = o; }
    LDS_WAIT();
}

#define PHASE_IDS() int tid_ = threadIdx.x; asm volatile("" : "+v"(tid_)); const int tid = tid_, lane = tid & 63, wave = __builtin_amdgcn_readfirstlane(tid >> 6); \
    const int gw = blockIdx.x * NWAVES + wave, NGW = gridDim.x * NWAVES; (void)lane; (void)gw; (void)NGW
__device__ __forceinline__ void adaln_gemv(const Params& p, int lo, int hi, int first_wg) {
    PHASE_IDS();
    if ((int)blockIdx.x < first_wg) return;
    const int wg = ((int)blockIdx.x - first_wg) * NWAVES + wave, nwg = ((int)gridDim.x - first_wg) * NWAVES;
    float* mod = (float*)(p.ws + WS_MOD);
    for (int it = lo + wg; it < hi; it += nwg) {
        const int i = it / 3072, r = it % 3072, kc = r / 48, cgp = r % 48, col = cgp * 256 + lane * 4;
        const float* W = p.w_ada + (size_t)i * DM * NMODC + (size_t)(kc * 32) * NMODC + col;
        f32x4 a0 = {0.f, 0.f, 0.f, 0.f}, a1 = {0.f, 0.f, 0.f, 0.f};
#pragma unroll 8
        for (int k = 0; k < 32; ++k) { const f32x4 w = *(const f32x4*)(W + (size_t)k * NMODC);
            const float s0 = silu_f(p.c[kc * 32 + k]), s1 = silu_f(p.c_ctx[kc * 32 + k]); a0 += w * s0; a1 += w * s1; }
        if (kc == 0) { const f32x4 b = *(const f32x4*)(p.b_ada + (size_t)i * NMODC + col); a0 += b; a1 += b; }
        float* m0 = mod + (size_t)(i * 2 + 0) * NMODC + col; float* m1 = mod + (size_t)(i * 2 + 1) * NMODC + col;
        atomicAdd(m0 + 0, a0.x); atomicAdd(m0 + 1, a0.y); atomicAdd(m0 + 2, a0.z); atomicAdd(m0 + 3, a0.w);
        atomicAdd(m1 + 0, a1.x); atomicAdd(m1 + 1, a1.y); atomicAdd(m1 + 2, a1.z); atomicAdd(m1 + 3, a1.w);
    }
}
__device__ __forceinline__ void prologue_phase(const Params& p, LAS unsigned char* lds) {
    PHASE_IDS();
    if (blockIdx.x == 0) { float* gt = (float*)(p.ws + WS_GTAB);
        for (int q = tid; q < 896; q += NTHR) gt[q] = q < 128 ? p.a_qk_g[q] : q < 384 ? p.b_qk_g[q - 128] : q < 640 ? p.c_qk_g[q - 384] : p.d_qk_g[q - 640]; }
}

constexpr int I_IN = (DM / 64) * (INW / 64), I_OUT = (DM / 64) * (DM / 64), I_UP = (DM / 64) * (UPW / 64), I_DN = (DFF / 64) * (DM / 64), I_L = I_IN + I_OUT + I_UP + I_DN;
__device__ __forceinline__ void convert_items(const Params& p, LAS unsigned char* lds, int lo, int hi, int first_wg) {
    PHASE_IDS();
    if ((int)blockIdx.x < first_wg) return;
    LAS float* scr = (LAS float*)(lds + wave * 16640);
    bf16_t* Win = (bf16_t*)(p.ws + WS_WIN); bf16_t* Wout = (bf16_t*)(p.ws + WS_WOUT); bf16_t* Wup = (bf16_t*)(p.ws + WS_WUP); bf16_t* Wdn = (bf16_t*)(p.ws + WS_WDN);
    const int wg = ((int)blockIdx.x - first_wg) * NWAVES + wave, nwg = ((int)gridDim.x - first_wg) * NWAVES;
    for (int it = lo + wg; it < hi; it += nwg) {
        const int i = it / I_L; int r = it % I_L;
        if (r < I_IN) { const int n0 = (r % (INW / 64)) * 64;
            const bool sw = (i == 0) ? (n0 >= 3072 && n0 < 4352) : (n0 < 1280);
            transpose_item(p.w_in + (size_t)i * DM * INW, DM, INW, Win + (size_t)i * INW * DM, scr, r, lane, false, sw); continue; } r -= I_IN;
        if (r < I_OUT) { transpose_item(p.w_out + (size_t)i * DM * DM, DM, DM, Wout + (size_t)i * DM * DM, scr, r, lane); continue; } r -= I_OUT;
        if (r < I_UP) { transpose_item(p.w_up + (size_t)i * DM * UPW, DM, UPW, Wup + (size_t)i * UPW * DM, scr, r, lane, true); continue; } r -= I_UP;
        transpose_item(p.w_down + (size_t)i * DFF * DM, DFF, DM, Wdn + (size_t)i * DM * DFF, scr, r, lane);
    }
}

__device__ __forceinline__ void norm_store(const f32x4 (&v)[8], float rstd, int gr, const float* __restrict__ g, const float* md, bf16_t* __restrict__ H, float* copy_ctx, int lane) {
#pragma unroll
    for (int j = 0; j < 8; ++j) { const int col = 4 * lane + 256 * j;
        if (copy_ctx && gr < CTX) *((f32x4*)(copy_ctx + (size_t)gr * DM) + lane + 64 * j) = v[j];
        const f32x4 g4 = *(const f32x4*)(g + col), sh = *(const f32x4*)(md + col), sc = *(const f32x4*)(md + DM + col);
        const f32x4 y = (v[j] * rstd) * g4, o = y * (sc + 1.f) + sh;
        v2u w; w.x = pk2(o.x, o.y); w.y = pk2(o.z, o.w);
        *(v2u*)(H + (size_t)gr * DM + col) = w; }
}
__device__ __forceinline__ void norm_phase(const float* src_ctx, const float* src_lat, const float* __restrict__ g, const float* mod_lat, const float* mod_ctx, int sidx,
                                           bf16_t* __restrict__ H, int row_lo, float* copy_ctx = nullptr) {
    PHASE_IDS();
    for (int gr0 = row_lo + gw; gr0 < MTOT; gr0 += 2 * NGW) {
        const int gr1 = gr0 + NGW; const bool has1 = gr1 < MTOT; const int grb = has1 ? gr1 : gr0;
        const float* xr0 = (gr0 < CTX ? src_ctx : src_lat) + (size_t)gr0 * DM; const float* xr1 = (grb < CTX ? src_ctx : src_lat) + (size_t)grb * DM;
        f32x4 v0[8], v1[8]; float ss0 = 0.f, ss1 = 0.f;
#pragma unroll
        for (int j = 0; j < 8; ++j) { v0[j] = *((const f32x4*)xr0 + lane + 64 * j); v1[j] = *((const f32x4*)xr1 + lane + 64 * j); }
#pragma unroll
        for (int j = 0; j < 8; ++j) { ss0 += (v0[j].x * v0[j].x + v0[j].y * v0[j].y) + (v0[j].z * v0[j].z + v0[j].w * v0[j].w); ss1 += (v1[j].x * v1[j].x + v1[j].y * v1[j].y) + (v1[j].z * v1[j].z + v1[j].w * v1[j].w); }
        const float rstd0 = rsqrtf(wave_sum(ss0) * (1.f / DM) + EPS), rstd1 = rsqrtf(wave_sum(ss1) * (1.f / DM) + EPS);
        norm_store(v0, rstd0, gr0, g, (gr0 < CTX ? mod_ctx : mod_lat) + (size_t)sidx * DM, H, copy_ctx, lane);
        if (has1) norm_store(v1, rstd1, gr1, g, (gr1 < CTX ? mod_ctx : mod_lat) + (size_t)sidx * DM, H, copy_ctx, lane);
    }
}

template <int LAYER>
__device__ __forceinline__ void qkrope_phase(const Params& p, bf16_t* P) {
    PHASE_IDS();
    for (int gr = gw; gr < MTOT + 128; gr += NGW) {
        if (gr >= MTOT) {
            for (int ch = lane; ch < INW / 8; ch += 64) *(v4u*)(P + (size_t)gr * INW + ch * 8) = (v4u){0u, 0u, 0u, 0u};
            continue;
        }
        const bool lat = gr >= CTX; const int tpos = gr - CTX;
#pragma unroll 1
        for (int it = 0; it < 7; ++it) {
            const int cgp = it * 64 + lane; const bool act = cgp < 416; const int ch = act ? cgp : 415;
            int col; bool w64; const float* g; bool rope;
            if (LAYER == 0) {
                col = ch < 256 ? 8 * ch : 3072 + 8 * (ch - 256); w64 = ch < 256; rope = lat;
                g = ch < 128 ? p.a_qk_g : ch < 256 ? p.a_qk_g + 64 : ch < 384 ? p.b_qk_g : p.b_qk_g + 128;
            } else {
                col = ch < 160 ? 8 * ch : 1536 + 8 * (ch - 160); w64 = false; rope = lat && ch < 160;
                g = ch < 128 ? p.c_qk_g : ch < 160 ? p.c_qk_g + 128 : ch < 288 ? p.d_qk_g : p.d_qk_g + 128;
            }
            bf16_t* ptr = P + (size_t)gr * INW + col;
            const v4u raw = *(const v4u*)ptr;
            float xv[8] = {bf_lo(raw.x), bf_hi(raw.x), bf_lo(raw.y), bf_hi(raw.y), bf_lo(raw.z), bf_hi(raw.z), bf_lo(raw.w), bf_hi(raw.w)};
            float ss = 0.f;
#pragma unroll
            for (int e = 0; e < 8; ++e) ss += xv[e] * xv[e];
            ss += __shfl_xor(ss, 1); ss += __shfl_xor(ss, 2); ss += __shfl_xor(ss, 4);
            const float ss8 = __shfl_xor(ss, 8);
            if (!w64) ss += ss8;
            const float rstd = rsqrtf(ss * (w64 ? 1.f / 64.f : 1.f / 128.f) + EPS);
            const int dbase = w64 ? (col & 63) : (col & 127);
            const f32x4 ga = *(const f32x4*)(g + dbase), gb = *(const f32x4*)(g + dbase + 4);
            const float gg[8] = {ga.x, ga.y, ga.z, ga.w, gb.x, gb.y, gb.z, gb.w};
#pragma unroll
            for (int e = 0; e < 8; ++e) xv[e] = xv[e] * rstd * gg[e];
            const int L = w64 ? (ch & 7) : (ch & 15);
            const int sub = w64 ? (L >> 2) : (L >> 3);
            const bool first = w64 ? ((L & 2) == 0) : ((L & 4) == 0);
            const int fi0 = w64 ? 8 * (L & 1) : 8 * (L & 3);
            const float fstep = w64 ? (-13.287712379549449f / 16.f) : (-13.287712379549449f / 32.f);
            const float pos = (float)(sub ? (tpos & 63) : (tpos >> 6));
            float ov[8];
#pragma unroll
            for (int e = 0; e < 8; ++e) {
                const float o2 = __shfl_xor(xv[e], 2), o4 = __shfl_xor(xv[e], 4);
                const float other = w64 ? o2 : o4;
                const float ang = pos * __builtin_amdgcn_exp2f((float)(fi0 + e) * fstep);
                const float cs = __cosf(ang), sn = __sinf(ang);
                const float rot = first ? xv[e] * cs - other * sn : xv[e] * cs + other * sn;
                ov[e] = rope ? rot : xv[e];
            }
            if (act) { v4u w; w.x = pk2(ov[0], ov[1]); w.y = pk2(ov[2], ov[3]); w.z = pk2(ov[4], ov[5]); w.w = pk2(ov[6], ov[7]); *(v4u*)ptr = w; }
        }
    }
}

__device__ __forceinline__ void conv_phase(const bf16_t* __restrict__ U, const float* __restrict__ cw, const float* __restrict__ cb, bf16_t* __restrict__ A2, int run_lo) {
    PHASE_IDS(); const long gtid = (long)blockIdx.x * NTHR + tid, NT_all = (long)gridDim.x * NTHR;
    constexpr int NCH = DFF / 8;
    for (long it = (long)run_lo * NCH + gtid; it < (long)(MTOT / 8) * NCH; it += NT_all) {
        const int run = (int)(it / NCH), ch = (int)(it % NCH), t0 = run * 8, c0 = ch * 8;
        const int lo = t0 < CTX ? 0 : CTX, hi = t0 < CTX ? CTX : MTOT;
        float wa[3][8], wg[3][8], ba[8], bg[8];
#pragma unroll
        for (int j = 0; j < 3; ++j)
#pragma unroll
            for (int e = 0; e < 8; e += 4) { const f32x4 a = *(const f32x4*)(cw + (size_t)j * UPW + c0 + e), g = *(const f32x4*)(cw + (size_t)j * UPW + DFF + c0 + e);
                wa[j][e] = a.x; wa[j][e + 1] = a.y; wa[j][e + 2] = a.z; wa[j][e + 3] = a.w; wg[j][e] = g.x; wg[j][e + 1] = g.y; wg[j][e + 2] = g.z; wg[j][e + 3] = g.w; }
#pragma unroll
        for (int e = 0; e < 8; e += 4) { const f32x4 a = *(const f32x4*)(cb + c0 + e), g = *(const f32x4*)(cb + DFF + c0 + e);
            ba[e] = a.x; ba[e + 1] = a.y; ba[e + 2] = a.z; ba[e + 3] = a.w; bg[e] = g.x; bg[e + 1] = g.y; bg[e + 2] = g.z; bg[e + 3] = g.w; }
        const v4u z = {0u, 0u, 0u, 0u};
        v4u pa = (t0 - 1 >= lo) ? *(const v4u*)(U + (size_t)(t0 - 1) * UPW + c0) : z, pg = (t0 - 1 >= lo) ? *(const v4u*)(U + (size_t)(t0 - 1) * UPW + DFF + c0) : z;
        v4u ca = *(const v4u*)(U + (size_t)t0 * UPW + c0), cg_ = *(const v4u*)(U + (size_t)t0 * UPW + DFF + c0);
#pragma unroll
        for (int r = 0; r < 8; ++r) {
            const int t = t0 + r;
            const v4u na = (t + 1 < hi) ? *(const v4u*)(U + (size_t)(t + 1) * UPW + c0) : z, ng = (t + 1 < hi) ? *(const v4u*)(U + (size_t)(t + 1) * UPW + DFF + c0) : z;
            float oa[8], og[8];
#define CONV2(k, PW, CW_, NW_, OUT, WT, BS) OUT[2 * k] = BS[2 * k] + bf_lo(PW) * WT[0][2 * k] + bf_lo(CW_) * WT[1][2 * k] + bf_lo(NW_) * WT[2][2 * k]; \
                                              OUT[2 * k + 1] = BS[2 * k + 1] + bf_hi(PW) * WT[0][2 * k + 1] + bf_hi(CW_) * WT[1][2 * k + 1] + bf_hi(NW_) * WT[2][2 * k + 1];
            CONV2(0, pa.x, ca.x, na.x, oa, wa, ba) CONV2(1, pa.y, ca.y, na.y, oa, wa, ba) CONV2(2, pa.z, ca.z, na.z, oa, wa, ba) CONV2(3, pa.w, ca.w, na.w, oa, wa, ba)
            CONV2(0, pg.x, cg_.x, ng.x, og, wg, bg) CONV2(1, pg.y, cg_.y, ng.y, og, wg, bg) CONV2(2, pg.z, cg_.z, ng.z, og, wg, bg) CONV2(3, pg.w, cg_.w, ng.w, og, wg, bg)
#undef CONV2
            float y[8];
#pragma unroll
            for (int e = 0; e < 8; ++e) y[e] = silu_f(og[e]) * oa[e];
            v4u w; w.x = pk2(y[0], y[1]); w.y = pk2(y[2], y[3]); w.z = pk2(y[4], y[5]); w.w = pk2(y[6], y[7]);
            *(v4u*)(A2 + (size_t)t * DFF + c0) = w;
            pa = ca; pg = cg_; ca = na; cg_ = ng;
        }
    }
}

__device__ __forceinline__ void conv_fix_phase(const bf16_t* __restrict__ U, const float* __restrict__ cw, const float* __restrict__ cb, bf16_t* __restrict__ A2, int tile_lo) {
    PHASE_IDS(); const long gtid = (long)blockIdx.x * NTHR + tid, NT_all = (long)gridDim.x * NTHR;
    constexpr int NCH = DFF / 8;
    for (long it = (long)tile_lo * 8 * NCH + gtid; it < (long)(MTOT / 256) * 8 * NCH; it += NT_all) {
        const int rk = (int)(it / NCH), ch = (int)(it % NCH), c0 = ch * 8, tile = rk >> 3, k = rk & 7;
        const int t = tile * 256 + ((k + 1) >> 1) * 64 - (k & 1);
        const int lo = t < CTX ? 0 : CTX, hi = t < CTX ? CTX : MTOT;
        const v4u z = {0u, 0u, 0u, 0u};
        const v4u pa = (t - 1 >= lo) ? *(const v4u*)(U + (size_t)(t - 1) * UPW + c0) : z, pg = (t - 1 >= lo) ? *(const v4u*)(U + (size_t)(t - 1) * UPW + DFF + c0) : z;
        const v4u ca = *(const v4u*)(U + (size_t)t * UPW + c0), cg_ = *(const v4u*)(U + (size_t)t * UPW + DFF + c0);
        const v4u na = (t + 1 < hi) ? *(const v4u*)(U + (size_t)(t + 1) * UPW + c0) : z, ng = (t + 1 < hi) ? *(const v4u*)(U + (size_t)(t + 1) * UPW + DFF + c0) : z;
        const unsigned pav[4] = {pa.x, pa.y, pa.z, pa.w}, pgv[4] = {pg.x, pg.y, pg.z, pg.w}, cav[4] = {ca.x, ca.y, ca.z, ca.w}, cgv[4] = {cg_.x, cg_.y, cg_.z, cg_.w}, nav[4] = {na.x, na.y, na.z, na.w}, ngv[4] = {ng.x, ng.y, ng.z, ng.w};
        unsigned ow[4];
#pragma unroll
        for (int q = 0; q < 4; ++q) {
            float y[2];
#pragma unroll
            for (int e = 0; e < 2; ++e) { const int c = c0 + 2 * q + e;
                const float xa0 = e ? bf_hi(pav[q]) : bf_lo(pav[q]), xa1 = e ? bf_hi(cav[q]) : bf_lo(cav[q]), xa2 = e ? bf_hi(nav[q]) : bf_lo(nav[q]);
                const float xg0 = e ? bf_hi(pgv[q]) : bf_lo(pgv[q]), xg1 = e ? bf_hi(cgv[q]) : bf_lo(cgv[q]), xg2 = e ? bf_hi(ngv[q]) : bf_lo(ngv[q]);
                const float oa = cb[c] + xa0 * cw[c] + xa1 * cw[UPW + c] + xa2 * cw[2 * UPW + c];
                const float og = cb[DFF + c] + xg0 * cw[DFF + c] + xg1 * cw[UPW + DFF + c] + xg2 * cw[2 * UPW + DFF + c];
                y[e] = silu_f(og) * oa; }
            ow[q] = pk2(y[0], y[1]);
        }
        *(v4u*)(A2 + (size_t)t * DFF + c0) = (v4u){ow[0], ow[1], ow[2], ow[3]};
    }
}

__device__ __forceinline__ void zero_pad_rows(bf16_t* P) {
    PHASE_IDS();
    unsigned zz = 0u; asm volatile("" : "+v"(zz));
    for (int q = (int)blockIdx.x * NTHR + tid; q < 128 * INW / 8; q += (int)gridDim.x * NTHR) *(v4u*)(P + (size_t)MTOT * INW + (size_t)q * 8) = (v4u){zz, zz, zz, zz};
}

__device__ __forceinline__ void attn_store(att::f32x16 (&o)[4], float l, char* lds, bf16_t* Yb  ) {
    int tid_ = threadIdx.x; asm volatile("" : "+v"(tid_));
    const int tid = tid_, wid = tid >> 6, lane = tid & 63, r32 = lane & 31, hi = lane >> 5;
    float* li_l = (float*)(lds + att::OFF_WS) + wid * 64;
    float rli[16]; att::row_recips(l, li_l, r32, hi, rli);
#pragma unroll
    for (int r = 0; r < 16; ++r) { const int orow = wid * 32 + att::crow(r, hi);
#pragma unroll
        for (int d0 = 0; d0 < 4; ++d0) Yb[(size_t)orow * att::LDY + d0 * 32 + r32] = (bf16_t)f2bf(o[d0][r] * rli[r]); }
}

__device__ __forceinline__ void attn_store_f32(att::f32x16 (&o)[4], float l, char* lds, float* dst) {
    int tid_ = threadIdx.x; asm volatile("" : "+v"(tid_));
    const int tid = tid_, wid = tid >> 6, lane = tid & 63, r32 = lane & 31, hi = lane >> 5;
    float* li_l = (float*)(lds + att::OFF_WS) + wid * 64;
    float rli[16]; att::row_recips(l, li_l, r32, hi, rli);
#pragma unroll
    for (int r = 0; r < 16; ++r) { const int orow = wid * 32 + att::crow(r, hi);
#pragma unroll
        for (int d0 = 0; d0 < 4; ++d0) dst[orow * 128 + d0 * 32 + r32] = o[d0][r] * rli[r]; }
}

__device__ __forceinline__ void attn_layer0(const Params& p, char* lds, int vcu, int G) {
    const att::bf16* P = (const att::bf16*)(p.ws + WS_P); bf16_t* Y = (bf16_t*)(p.ws + WS_Y);
    int tid_ = threadIdx.x; asm volatile("" : "+v"(tid_));
    const int tid = tid_, wid = tid >> 6, lane = tid & 63;
    const att::MaskCtx mc{0, 0, 0, nullptr};
    float* o12 = (float*)(p.ws + WS_O1) + (size_t)blockIdx.x * 65536;
#pragma unroll 1
    for (int u = vcu; u < 264; u += G) {
        const bool lat = u < 256; const int h = lat ? u >> 5 : u - 256, row0 = lat ? CTX + (u & 31) * 256 : 0, NT = lat ? 132 : 4;
#pragma unroll 1
        for (int m = 0; m < 2; ++m) {
            att::f32x16 o[4]; float m_reg, l_reg;
            att::attn_core<64, 0>(P + (size_t)row0 * INW + h * 128 + m * 64, P + 1024 + h * 128 + m * 64, P + 2048 + h * 128, NT, 0, mc, lds, o, m_reg, l_reg);
            attn_store_f32(o, l_reg, lds, o12 + m * 32768);
        }
        asm volatile("s_waitcnt vmcnt(0)" ::: "memory");
        float s01 = 0.f, s23 = 0.f;
        for (int e = 0; e < 64; ++e) { s01 += p.a_lambda[e] * p.a_lambda[64 + e]; s23 += p.a_lambda[128 + e] * p.a_lambda[192 + e]; }
        const float lam = __expf(s01) - __expf(s23) + 0.2f;
        const float g0 = p.a_subln_g[2 * lane], g1 = p.a_subln_g[2 * lane + 1];
#pragma unroll 4
        for (int rr = 0; rr < 32; ++rr) {
            const int row = wid * 32 + rr;
            const float2 a = *(const float2*)(o12 + row * 128 + 2 * lane), b = *(const float2*)(o12 + 32768 + row * 128 + 2 * lane);
            const float d0 = a.x - lam * b.x, d1 = a.y - lam * b.y;
            const float sc = rsqrtf(wave_sum(d0 * d0 + d1 * d1) * (1.f / 128.f) + EPS) * 0.8f;
            *(unsigned*)(Y + (size_t)(row0 + row) * DM + h * 128 + 2 * lane) = pk2(d0 * sc * g0, d1 * sc * g1);
        }
    }
#pragma unroll 1
    for (int u = vcu; u < 264; u += G) {
        const bool lat = u < 256; const int h = lat ? u >> 5 : u - 256, row0 = lat ? CTX + (u & 31) * 256 : 0, NT = lat ? 132 : 4;
        att::f32x16 o[4]; float m_reg, l_reg;
        att::attn_core<128, 0>(P + (size_t)row0 * INW + 3072 + h * 128, P + 4096 + (h >> 2) * 128, P + 4352 + (h >> 2) * 128, NT, 0, mc, lds, o, m_reg, l_reg);
        attn_store(o, l_reg, lds, Y + (size_t)row0 * DM + 1024 + h * 128);
    }
}

__device__ __forceinline__ void attn_layer1(const Params& p, char* lds, int vcu, int G) {
    const att::bf16* P = (const att::bf16*)(p.ws + WS_P); bf16_t* Y = (bf16_t*)(p.ws + WS_Y);
    int tid_ = threadIdx.x; asm volatile("" : "+v"(tid_));
    const int tid = tid_, wid = tid >> 6, lane = tid & 63, r32 = lane & 31;
#pragma unroll 1
    for (int u = vcu; u < 256; u += G) {
        const int h = u >> 5, qb = u & 31, q0 = qb * 256, row0 = CTX + q0;
        const att::MaskCtx mc{q0 + wid * 32 + r32, q0 - 128, 0, nullptr};
        att::f32x16 o[4]; float m_reg, l_reg;
        att::attn_core<128, 1>(P + (size_t)row0 * INW + h * 128, P + 1024 + (h >> 2) * 128, P + 1280 + (h >> 2) * 128, 12, CTX + q0 - 128, mc, lds, o, m_reg, l_reg);
        constexpr float C = 0.088388347648318440f * 1.4426950408889634f;
        const float l = l_reg + __builtin_amdgcn_exp2f(p.c_sink[h] * 1.4426950408889634f - m_reg * C);
        attn_store(o, l, lds, Y + (size_t)row0 * DM + h * 128);
    }
    float* tab = (float*)(lds + att::OFF_TAB);
#pragma unroll 1
    for (int u = vcu; u < 256; u += G) {
        const int h = u >> 5, qb = u & 31, q0 = qb * 256, row0 = CTX + q0, r0 = qb * 4;
        const int base = min(max(r0 - 4, 0), 116);
        __syncthreads();
        if (tid < 465) tab[tid] = p.d_rpb[h * 465 + tid] * 11.313708498984761f;
        const att::MaskCtx mc{r0 + (wid >> 1), (wid & 1) * 32 + r32, base, tab};
        att::f32x16 o[4]; float m_reg, l_reg;
        att::attn_core<128, 2>(P + (size_t)row0 * INW + 1536 + h * 128, P + 2560 + h * 128, P + 3584 + h * 128, 16, CTX + base * 64, mc, lds, o, m_reg, l_reg);
        attn_store(o, l_reg, lds, Y + (size_t)row0 * DM + 1024 + h * 128);
    }
}

#define GAS __attribute__((address_space(1)))
typedef GAS unsigned gu32;
typedef GAS unsigned long long gu64;
#define RLX_AGENT __ATOMIC_RELAXED, __HIP_MEMORY_SCOPE_AGENT
#define XB_TMO      128
#define XB_XCNT(j)  (256  + 64 * (j))
#define XB_XSUB(j)  (1280 + 64 * (j))
#define XB_XGEN(j)  (2304 + 64 * (j))
#define XB_TOP      3328
#define XB_TOPGEN   3392
#define XCD_BAR_WORDS 3456
#define XB_SPIN_CAP (1u << 18)

__device__ __forceinline__ unsigned xb_ld(unsigned* p)              { return __hip_atomic_load(p, __ATOMIC_RELAXED, __HIP_MEMORY_SCOPE_AGENT); }
__device__ __forceinline__ unsigned xb_add(unsigned* p, unsigned v) { return __hip_atomic_fetch_add(p, v, __ATOMIC_RELAXED, __HIP_MEMORY_SCOPE_AGENT); }
__device__ __forceinline__ unsigned xb_xcc_id() { return (unsigned)__builtin_amdgcn_s_getreg((3 << 11) | 20) & 0xFu; }
#define XB_SPIN(cond, bar) do { unsigned _sp = 0; while (cond) { __builtin_amdgcn_s_sleep(1); \
    if ((++_sp & 255u) == 0u) { if (xb_ld(&(bar)[XB_TMO])) break; if (_sp > XB_SPIN_CAP) { atomicAdd(&(bar)[XB_TMO], 1u); break; } } } } while (0)

struct XcdBarrier {
    unsigned* bar; unsigned x;
    volatile LAS unsigned* st;
};

__device__ __forceinline__ XcdBarrier xcd_barrier_post(unsigned* bar, volatile LAS unsigned* st) {
    XcdBarrier b; b.bar = bar; b.x = xb_xcc_id(); b.st = st;
    if (threadIdx.x == 0) (void)xb_add(&bar[XB_XCNT(b.x)], 1u);
    return b;
}
__device__ __forceinline__ void xcd_barrier_complete(unsigned* bar, unsigned x, unsigned& nloc, unsigned& nx) {
    const unsigned G = gridDim.x * gridDim.y * gridDim.z;
    unsigned sum, cnt, mine, sp = 0u;
    for (;;) {
        sum = 0u; cnt = 0u; mine = 0u;
#pragma unroll
        for (unsigned j = 0; j < 16; ++j) { const unsigned c = xb_ld(&bar[XB_XCNT(j)]); sum += c; cnt += (c > 0u) ? 1u : 0u; mine = (j == x) ? c : mine; }
        if (sum == G) break;
        __builtin_amdgcn_s_sleep(1);
        if ((++sp & 255u) == 0u) { if (xb_ld(&bar[XB_TMO])) break; if (sp > XB_SPIN_CAP) { atomicAdd(&bar[XB_TMO], 1u); break; } }
    }
    nloc = mine > 0u ? mine : 1u; nx = cnt > 0u ? cnt : 1u;
}

__device__ __forceinline__ void xcd_barrier(const XcdBarrier& b) {
    asm volatile("s_waitcnt vmcnt(0)" ::: "memory");
    __syncthreads();
    if (threadIdx.x == 0) {
        unsigned* bar = b.bar; asm volatile("" : "+s"(bar));
        unsigned bx_ = b.x; asm volatile("" : "+s"(bx_));
        __builtin_amdgcn_s_waitcnt(0);
        unsigned nloc = b.st[0], nx = b.st[1];
        if (nloc == 0u) { xcd_barrier_complete(bar, bx_, nloc, nx); b.st[0] = nloc; b.st[1] = nx; }
        const unsigned old = xb_add(&bar[XB_XSUB(bx_)], 1u);
        const unsigned gen = old / nloc;
        if (old + 1u == (gen + 1u) * nloc) {
            __builtin_amdgcn_fence(__ATOMIC_RELEASE, "agent");
            asm volatile("s_waitcnt vmcnt(0)" ::: "memory");
            const unsigned og = xb_add(&bar[XB_TOP], 1u);
            const unsigned tg = og / nx;
            if (og + 1u == (tg + 1u) * nx) xb_add(&bar[XB_TOPGEN], 1u);
            else XB_SPIN(xb_ld(&bar[XB_TOPGEN]) == tg, bar);
            __builtin_amdgcn_fence(__ATOMIC_ACQUIRE, "agent");
            xb_add(&bar[XB_XGEN(bx_)], 1u);
            asm volatile("s_waitcnt vmcnt(0)" ::: "memory");
        } else {
            XB_SPIN(xb_ld(&bar[XB_XGEN(bx_)]) == gen, bar);
            __builtin_amdgcn_fence(__ATOMIC_ACQUIRE, "agent");
            asm volatile("s_waitcnt vmcnt(0)" ::: "memory");
        }
    }
    __syncthreads();
}

__global__ void __launch_bounds__(NTHR, 2) mega_fwd(Params p) {
    extern __shared__ __attribute__((aligned(16))) unsigned char lds_raw[];
    cg::grid_group grid = cg::this_grid();
    LAS unsigned char* lds = (LAS unsigned char*)lds_raw;
    const int G = gridDim.x, bx = blockIdx.x, vcu = (G % 8 == 0) ? (bx % 8) * (G / 8) + bx / 8 : bx;
    unsigned char* ws = p.ws;
    float* mod = (float*)(ws + WS_MOD);
    bf16_t* H = (bf16_t*)(ws + WS_H); float* XR = (float*)(ws + WS_XR); bf16_t* A2 = (bf16_t*)(ws + WS_A2); bf16_t* U = (bf16_t*)(ws + WS_U);
    bf16_t* P = (bf16_t*)(ws + WS_P); bf16_t* Y = (bf16_t*)(ws + WS_Y);

    volatile LAS unsigned* misc = (volatile LAS unsigned*)(lds + MISC_OFF);
    if (threadIdx.x < 2) misc[threadIdx.x] = 0u;
    __syncthreads();
    const XcdBarrier bar = xcd_barrier_post((unsigned*)(ws + WS_BAR), misc);
#define GRID_SYNC() xcd_barrier(bar)
    prologue_phase(p, lds);
    adaln_gemv(p, 0, 3072, 0);
    convert_items(p, lds, 0, I_IN, 0);
    if (p.ws == nullptr) grid.sync();
    GRID_SYNC();
#pragma unroll 1
    for (int i = 0; i < 2; ++i) {
        const float* mod_lat = mod + (size_t)(i * 2 + 0) * NMODC; const float* mod_ctx = mod + (size_t)(i * 2 + 1) * NMODC;
        const bf16_t* Win = (const bf16_t*)(ws + WS_WIN) + (size_t)i * INW * DM; const bf16_t* Wout = (const bf16_t*)(ws + WS_WOUT) + (size_t)i * DM * DM;
        const bf16_t* Wup = (const bf16_t*)(ws + WS_WUP) + (size_t)i * UPW * DM; const bf16_t* Wdn = (const bf16_t*)(ws + WS_WDN) + (size_t)i * DM * DFF;
        if (i == 0) norm_phase(p.ctx, p.x - (size_t)CTX * DM, p.norm1_g, mod_lat, mod_ctx, 0, H, 0, XR);
        else      { norm_phase(XR, XR, p.norm1_g + DM, mod_lat, mod_ctx, 0, H, 0); zero_pad_rows(P); }
        GRID_SYNC();
        { pg8::Gemm g{H, Win, MTOT, INW, DM, DM}; pg8::StaticOrder S; S.init(MTOT, INW, G, bx);
          PG8_LAS float* part = (PG8_LAS float*)(lds + 131072);
          if (i == 0) { const pg8::EpiQKV<0> E{P, (const float*)(ws + WS_GTAB), part}; pg8::gemm_phase<pg8::EpiQKV<0>, pg8::StaticOrder, true, true>(lds, g, S, E); }
          else        { const pg8::EpiQKV<1> E{P, (const float*)(ws + WS_GTAB) + 384, part}; pg8::gemm_phase<pg8::EpiQKV<1>, pg8::StaticOrder, true, true>(lds, g, S, E); } }
        if (i == 0) convert_items(p, lds, I_IN, I_IN + I_OUT + I_UP, ((MTOT / 256) * (INW / 256)) % G);
        else        convert_items(p, lds, I_L + I_IN, 2 * I_L, ((MTOT / 256) * (INW / 256)) % G);
        GRID_SYNC();
        if (i == 0) attn_layer0(p, (char*)lds_raw, vcu, G); else attn_layer1(p, (char*)lds_raw, vcu, G);
        GRID_SYNC();
        { const pg8::Gemm g{Y + (size_t)CTX * DM, Wout, SEQ, DM, DM, DM};
          pg8::StaticOrder S; S.init(SEQ, DM, G, bx);
          const pg8::EpiGateRes E{XR, (i == 0) ? p.x - (size_t)CTX * DM : XR, XR, mod_ctx + 2 * DM, mod_lat + 2 * DM, CTX};
          pg8::gemm_phase<pg8::EpiGateRes, pg8::StaticOrder, true, true>(lds, g, S, E); }
        if (i == 0) { const pg8::Gemm g{Y, Wout, CTX, DM, 256, DM};
          const pg8::SplitKOrder S{DM / 256, (DM / 256) * (DM / 256), 256, G, bx};
          const pg8::EpiGateAtomic E{XR, mod_ctx + 2 * DM};
          pg8::gemm_phase<pg8::EpiGateAtomic, pg8::SplitKOrder, false, true>(lds, g, S, E); }
        GRID_SYNC();
        norm_phase(XR, XR, p.norm2_g + (size_t)i * DM, mod_lat, mod_ctx, 3, H, i == 0 ? 0 : CTX);
        GRID_SYNC();
        { const pg8::Gemm g = (i == 0) ? pg8::Gemm{H, Wup, MTOT, UPW, DM, DM} : pg8::Gemm{H + (size_t)CTX * DM, Wup, SEQ, UPW, DM, DM};
          pg8::StaticOrder S; S.init(g.M, UPW, G, bx);
          const pg8::EpiConvGate E{A2, U, p.conv_w + (size_t)i * 3 * UPW, p.conv_b + (size_t)i * UPW, (i == 0) ? 0 : CTX};
          pg8::gemm_phase<pg8::EpiConvGate, pg8::StaticOrder, true, true>(lds, g, S, E); }
        if (i == 0) convert_items(p, lds, I_IN + I_OUT + I_UP, I_L + I_IN, ((MTOT / 256) * (UPW / 256)) % G);
        GRID_SYNC();
        conv_fix_phase(U, p.conv_w + (size_t)i * 3 * UPW, p.conv_b + (size_t)i * UPW, A2, i == 0 ? 0 : 1);
        GRID_SYNC();
        { const pg8::Gemm g{A2 + (size_t)CTX * DFF, Wdn, SEQ, DM, DFF, DFF};
          pg8::StaticOrder S; S.init(SEQ, DM, G, bx);
          const pg8::EpiGateRes E{XR, XR, (i == 0) ? XR : p.out - (size_t)CTX * DM, mod_ctx + 5 * DM, mod_lat + 5 * DM, CTX};
          pg8::gemm_phase<pg8::EpiGateRes, pg8::StaticOrder, true, true>(lds, g, S, E); }
        if (i == 0) { const pg8::Gemm g{A2, Wdn, CTX, DM, 512, DFF};
          const pg8::SplitKOrder S{DM / 256, (DM / 256) * (DFF / 512), 512, G, bx};
          const pg8::EpiGateAtomic E{XR, mod_ctx + 5 * DM};
          pg8::gemm_phase<pg8::EpiGateAtomic, pg8::SplitKOrder, false, true>(lds, g, S, E); }
        if (i == 0) { adaln_gemv(p, 3072, 6144, ((DM / 256) * (DFF / 512)) % G); GRID_SYNC(); }
    }
}

extern "C" void kernel_launch(void* const* d_in, const int* in_sizes, int n_in, void* d_out, int out_size, void* d_ws, size_t ws_size, hipStream_t stream) {
    static int grid = 0;
    if (grid == 0) {
        if (n_in != 22 || in_sizes[0] != SEQ * DM || out_size != SEQ * DM || ws_size < WS_END) {
            fprintf(stderr, "kernel_launch: unexpected shapes (n_in %d, in0 %d, out %d, ws %zu < %zu); nothing launched\n", n_in, n_in > 0 ? in_sizes[0] : -1, out_size, ws_size, (size_t)WS_END);
            grid = -1; return; }
        int dev = 0, cus = 0, per_cu = 0;
        (void)hipGetDevice(&dev); (void)hipDeviceGetAttribute(&cus, hipDeviceAttributeMultiprocessorCount, dev);
        if (hipFuncSetAttribute((const void*)mega_fwd, hipFuncAttributeMaxDynamicSharedMemorySize, LDS_BYTES) != hipSuccess) { fprintf(stderr, "kernel_launch: hipFuncSetAttribute failed\n"); grid = -1; return; }
        if (hipOccupancyMaxActiveBlocksPerMultiprocessor(&per_cu, (const void*)mega_fwd, NTHR, LDS_BYTES) != hipSuccess || per_cu < 1) { (void)hipGetLastError(); per_cu = 1; }
        grid = cus * (per_cu > 1 ? 1 : per_cu);
        if (grid <= 0) grid = 256;
    }
    if (grid < 0) return;
    (void)hipMemsetAsync((char*)d_ws + WS_MOD, 0, CTL_ZERO_BYTES, stream);
    Params p{};
    const float** pp = (const float**)&p;
    for (int i = 0; i < 22; ++i) pp[i] = (const float*)d_in[i];
    p.out = (float*)d_out; p.ws = (unsigned char*)d_ws;
    void* args[] = {&p};
    hipError_t e = hipLaunchCooperativeKernel((const void*)mega_fwd, dim3(grid), dim3(NTHR), args, LDS_BYTES, stream);
    if (e != hipSuccess) fprintf(stderr, "cooperative launch failed: %s (grid %d)\n", hipGetErrorString(e), grid);
}
```
